# Optimizing an MI355X kernel written in HIP

```python
import math
import jax, jax.numpy as jnp
from jax import lax
import numpy as np

D_MODEL = 1024
BATCH = 4
SEQ = 8192
DEPTH = 4

N_A_LAYERS = DEPTH // 2
N_B_LAYERS = DEPTH - N_A_LAYERS
RET_HEADS = 8
RET_QK_DIM = D_MODEL // RET_HEADS
RET_V_DIM = 2 * RET_QK_DIM
RET_V_WIDTH = RET_HEADS * RET_V_DIM
RET_CHUNK = 128
RET_ROPE_THETA = 10000.0
DIFF_HEAD_DIM = 64
DIFF_HEADS = D_MODEL // (2 * DIFF_HEAD_DIM)
DIFF_QK_WIDTH = DIFF_HEADS * 2 * DIFF_HEAD_DIM
DIFF_V_DIM = 2 * DIFF_HEAD_DIM
DIFF_V_WIDTH = DIFF_HEADS * DIFF_V_DIM
ROPE_THETA = 500000.0
ROPE_DIM = DIFF_HEAD_DIM // 4
Q_BLOCK = 128
NEG_BIG = -1e30
N_EXPERTS = 32
TOP_K = 4
D_FF = D_MODEL
SWIGLU_ALPHA = 1.702
SWIGLU_LIMIT = 7.0
MOE_BLOCK = 256
DN_ALPHA = (2 * DEPTH) ** 0.25
DN_BETA = (8 * DEPTH) ** -0.25
LN_EPS = 1e-5

kernel_name = "yoco_retention_diffattn_moe_deepnorm"


def layer_norm(x, g, b):
    xf = x.astype(jnp.float32)
    mu = jnp.mean(xf, -1, keepdims=True)
    var = jnp.mean(jnp.square(xf - mu), -1, keepdims=True)
    return ((xf - mu) * lax.rsqrt(var + LN_EPS) * g + b).astype(x.dtype)


def apply_rope(x, inv_freq):
    s = x.shape[1]
    rot = 2 * inv_freq.shape[0]
    ang = jnp.arange(s, dtype=jnp.float32)[:, None] * inv_freq[None, :]
    shape = (s,) + (1,) * (x.ndim - 3) + (rot // 2,)
    cos = jnp.cos(ang).reshape(shape)
    sin = jnp.sin(ang).reshape(shape)
    xr = x[..., :rot].astype(jnp.float32)
    x1, x2 = xr[..., : rot // 2], xr[..., rot // 2:]
    rotated = jnp.concatenate([x1 * cos - x2 * sin, x2 * cos + x1 * sin], -1).astype(x.dtype)
    return jnp.concatenate([rotated, x[..., rot:]], -1)


def partial_inv_freq():
    return 1.0 / (ROPE_THETA ** (jnp.arange(0, ROPE_DIM, 2, dtype=jnp.float32) / ROPE_DIM))


def retention(x, w_in, w_out):
    b, s, _ = x.shape
    h, dk, dv, c = RET_HEADS, RET_QK_DIM, RET_V_DIM, RET_CHUNK
    n = s // c
    proj = x @ w_in
    q, k, v, g = jnp.split(proj, [D_MODEL, 2 * D_MODEL, 2 * D_MODEL + RET_V_WIDTH], -1)
    inv_freq = 1.0 / (RET_ROPE_THETA ** jnp.linspace(0.0, 1.0, dk // 2, dtype=jnp.float32))
    q = apply_rope(q.reshape(b, s, h, dk), inv_freq)
    k = apply_rope(k.reshape(b, s, h, dk), inv_freq) * (dk ** -0.5)
    v = v.reshape(b, s, h, dv)

    def chunks(t):
        return t.reshape(b, n, c, h, -1).transpose(0, 3, 1, 2, 4).astype(jnp.float32)

    qc, kc, vc = chunks(q), chunks(k), chunks(v)
    log_gamma = jnp.log1p(-jnp.exp2(-5.0 - jnp.arange(h, dtype=jnp.float32)))
    idx = jnp.arange(c, dtype=jnp.float32)
    rel = idx[:, None] - idx[None, :]
    dmask = jnp.where(rel >= 0, jnp.exp(jnp.maximum(rel, 0.0) * log_gamma[:, None, None]), 0.0)
    scores = jnp.einsum('bhncd,bhnmd->bhncm', qc, kc) * dmask[:, None]
    o_inner = jnp.einsum('bhncm,bhnme->bhnce', scores, vc)
    k_decay = jnp.exp((c - 1 - idx) * log_gamma[:, None])
    q_decay = jnp.exp((idx + 1) * log_gamma[:, None])
    chunk_decay = jnp.exp(c * log_gamma)[:, None, None]
    kv = jnp.einsum('bhnmd,bhnme->nbhde', kc * k_decay[:, None, :, None], vc)

    def step(state, inp):
        q_n, kv_n = inp
        cross = jnp.einsum('bhcd,bhde->bhce', q_n, state)
        return chunk_decay * state + kv_n, cross

    state0 = jnp.zeros((b, h, dk, dv), jnp.float32)
    _, cross = lax.scan(step, state0, (qc.transpose(2, 0, 1, 3, 4), kv))
    o = o_inner + cross.transpose(1, 2, 0, 3, 4) * q_decay[:, None, :, None]
    mu = jnp.mean(o, -1, keepdims=True)
    var = jnp.mean(jnp.square(o - mu), -1, keepdims=True)
    o = (o - mu) * lax.rsqrt(var + LN_EPS)
    o = o.transpose(0, 2, 3, 1, 4).reshape(b, s, RET_V_WIDTH).astype(x.dtype)
    return (o * jax.nn.silu(g)) @ w_out


def shared_kv(x, w_kv):
    b, s, _ = x.shape
    kv = x @ w_kv
    k, v = jnp.split(kv, [DIFF_QK_WIDTH], -1)
    k = apply_rope(k.reshape(b, s, DIFF_HEADS, 2, DIFF_HEAD_DIM), partial_inv_freq())
    v = v.reshape(b, s, DIFF_HEADS, DIFF_V_DIM)
    return k, v


def diff_attention(x, k, v, w_q, lam, subln_g, w_out, lambda_init):
    b, s, _ = x.shape
    q = apply_rope((x @ w_q).reshape(b, s, DIFF_HEADS, 2, DIFF_HEAD_DIM), partial_inv_freq())
    q = q * (DIFF_HEAD_DIM ** -0.5)
    lam_f = lam.astype(jnp.float32)
    lam_full = (jnp.exp(jnp.sum(lam_f[0] * lam_f[1])) - jnp.exp(jnp.sum(lam_f[2] * lam_f[3]))
                + lambda_init)
    nq = s // Q_BLOCK
    qb = q.reshape(b, nq, Q_BLOCK, DIFF_HEADS, 2, DIFF_HEAD_DIM).transpose(1, 0, 2, 3, 4, 5)
    key_pos = jnp.arange(s)

    def block(inp):
        q_blk, i = inp
        q_pos = i * Q_BLOCK + jnp.arange(Q_BLOCK)
        sc = jnp.einsum('bqhcd,bkhcd->bhcqk', q_blk, k).astype(jnp.float32)
        sc = jnp.where(key_pos[None, :] <= q_pos[:, None], sc, NEG_BIG)
        p = jax.nn.softmax(sc, axis=-1)
        a = p[:, :, 0] - lam_full * p[:, :, 1]
        return jnp.einsum('bhqk,bkhe->bqhe', a.astype(v.dtype), v)

    o = lax.map(block, (qb, jnp.arange(nq)))
    o = o.transpose(1, 0, 2, 3, 4).reshape(b, s, DIFF_HEADS, DIFF_V_DIM).astype(jnp.float32)
    o = o * lax.rsqrt(jnp.mean(o * o, -1, keepdims=True) + LN_EPS) * subln_g * (1.0 - lambda_init)
    return o.reshape(b, s, DIFF_V_WIDTH).astype(x.dtype) @ w_out


def moe(x, w_router, b_router, w_up, b_up, w_down, b_down):
    b, s, d = x.shape
    t = b * s
    xf = x.reshape(t, d)
    logits = (xf @ w_router + b_router).astype(jnp.float32)
    top_val, top_idx = lax.top_k(logits, TOP_K)
    gates = jax.nn.softmax(top_val, axis=-1)
    flat_e = top_idx.reshape(-1)
    flat_tok = jnp.arange(t * TOP_K, dtype=jnp.int32) // TOP_K
    flat_gate = gates.reshape(-1)
    order = jnp.argsort(flat_e)
    sorted_e = flat_e[order]
    counts = jnp.zeros((N_EXPERTS,), jnp.int32).at[flat_e].add(1)
    offsets = jnp.cumsum(counts) - counts
    padded = (counts + MOE_BLOCK - 1) // MOE_BLOCK * MOE_BLOCK
    padded_end = jnp.cumsum(padded)
    padded_off = padded_end - padded
    rank = jnp.arange(t * TOP_K, dtype=jnp.int32) - offsets[sorted_e]
    dest = padded_off[sorted_e] + rank
    n_rows = t * TOP_K + N_EXPERTS * MOE_BLOCK
    n_blocks = n_rows // MOE_BLOCK
    row_tok = jnp.full((n_rows,), t, jnp.int32).at[dest].set(flat_tok[order])
    row_gate = jnp.zeros((n_rows,), jnp.float32).at[dest].set(flat_gate[order])
    block_e = jnp.minimum(
        jnp.searchsorted(padded_end, jnp.arange(n_blocks, dtype=jnp.int32) * MOE_BLOCK, side='right'),
        N_EXPERTS - 1)
    x_pad = jnp.concatenate([xf, jnp.zeros((1, d), xf.dtype)], 0)
    xs = x_pad[row_tok].reshape(n_blocks, MOE_BLOCK, d)

    def expert_block(inp):
        xb, e = inp
        hdn = xb @ w_up[e] + b_up[e]
        glu, lin = jnp.split(hdn, 2, -1)
        glu = jnp.minimum(glu, SWIGLU_LIMIT)
        lin = jnp.clip(lin, -SWIGLU_LIMIT, SWIGLU_LIMIT)
        hdn = glu * jax.nn.sigmoid(SWIGLU_ALPHA * glu) * (lin + 1.0)
        return hdn @ w_down[e] + b_down[e]

    ys = lax.map(expert_block, (xs, block_e)).reshape(n_rows, d)
    ys = ys * row_gate[:, None].astype(ys.dtype)
    out = jax.ops.segment_sum(ys, row_tok, num_segments=t + 1)[:t]
    return out.reshape(b, s, d)


def setup_inputs(seed: int = 0) -> dict:
    key = jax.random.key(seed)
    ks = jax.random.split(key, 24)
    f32 = jnp.float32

    def nrm(k, shape, scale):
        return jax.random.normal(k, shape, f32) * scale

    din = D_MODEL ** -0.5
    x = nrm(ks[0], (BATCH, SEQ, D_MODEL), 1.0)
    ret_w_in = jnp.concatenate([
        nrm(ks[1], (N_A_LAYERS, D_MODEL, 2 * D_MODEL), din),
        nrm(ks[2], (N_A_LAYERS, D_MODEL, RET_V_WIDTH), din * DN_BETA),
        nrm(ks[3], (N_A_LAYERS, D_MODEL, RET_V_WIDTH), din),
    ], -1)
    ret_w_out = nrm(ks[4], (N_A_LAYERS, RET_V_WIDTH, D_MODEL), RET_V_WIDTH ** -0.5 * DN_BETA)
    kv_w = jnp.concatenate([
        nrm(ks[5], (D_MODEL, DIFF_QK_WIDTH), din),
        nrm(ks[6], (D_MODEL, DIFF_V_WIDTH), din * DN_BETA),
    ], -1)
    diff_w_q = nrm(ks[7], (N_B_LAYERS, D_MODEL, DIFF_QK_WIDTH), din)
    diff_lambda = nrm(ks[8], (N_B_LAYERS, 4, DIFF_HEAD_DIM), 0.1)
    diff_subln_g = 1.0 + nrm(ks[9], (N_B_LAYERS, DIFF_V_DIM), 0.02)
    diff_w_out = nrm(ks[10], (N_B_LAYERS, DIFF_V_WIDTH, D_MODEL), DIFF_V_WIDTH ** -0.5 * DN_BETA)
    ln_attn_g = 1.0 + nrm(ks[11], (DEPTH, D_MODEL), 0.02)
    ln_attn_b = nrm(ks[12], (DEPTH, D_MODEL), 0.02)
    ln_ffn_g = 1.0 + nrm(ks[13], (DEPTH, D_MODEL), 0.02)
    ln_ffn_b = nrm(ks[14], (DEPTH, D_MODEL), 0.02)
    moe_w_router = nrm(ks[15], (DEPTH, D_MODEL, N_EXPERTS), din)
    moe_b_router = nrm(ks[16], (DEPTH, N_EXPERTS), 0.01)
    moe_w_up = nrm(ks[17], (DEPTH, N_EXPERTS, D_MODEL, 2 * D_FF), din * DN_BETA)
    moe_b_up = nrm(ks[18], (DEPTH, N_EXPERTS, 2 * D_FF), 0.01)
    moe_w_down = nrm(ks[19], (DEPTH, N_EXPERTS, D_FF, D_MODEL), D_FF ** -0.5 * DN_BETA)
    moe_b_down = nrm(ks[20], (DEPTH, N_EXPERTS, D_MODEL), 0.01)
    return {"x": x, "ret_w_in": ret_w_in, "ret_w_out": ret_w_out, "kv_w": kv_w,
            "diff_w_q": diff_w_q, "diff_lambda": diff_lambda, "diff_subln_g": diff_subln_g,
            "diff_w_out": diff_w_out, "ln_attn_g": ln_attn_g, "ln_attn_b": ln_attn_b,
            "ln_ffn_g": ln_ffn_g, "ln_ffn_b": ln_ffn_b, "moe_w_router": moe_w_router,
            "moe_b_router": moe_b_router, "moe_w_up": moe_w_up, "moe_b_up": moe_b_up,
            "moe_w_down": moe_w_down, "moe_b_down": moe_b_down}


def reference(x, ret_w_in, ret_w_out, kv_w, diff_w_q, diff_lambda, diff_subln_g, diff_w_out,
              ln_attn_g, ln_attn_b, ln_ffn_g, ln_ffn_b, moe_w_router, moe_b_router,
              moe_w_up, moe_b_up, moe_w_down, moe_b_down):
    h = x
    k_sh, v_sh = None, None
    for l in range(DEPTH):
        if l < N_A_LAYERS:
            mix = retention(h, ret_w_in[l], ret_w_out[l])
        else:
            j = l - N_A_LAYERS
            lambda_init = 0.8 - 0.6 * math.exp(-0.3 * l)
            mix = diff_attention(h, k_sh, v_sh, diff_w_q[j], diff_lambda[j], diff_subln_g[j],
                                 diff_w_out[j], lambda_init)
        h = layer_norm(DN_ALPHA * h + mix, ln_attn_g[l], ln_attn_b[l])
        ffn = moe(h, moe_w_router[l], moe_b_router[l], moe_w_up[l], moe_b_up[l],
                  moe_w_down[l], moe_b_down[l])
        h = layer_norm(DN_ALPHA * h + ffn, ln_ffn_g[l], ln_ffn_b[l])
        if l == N_A_LAYERS - 1:
            k_sh, v_sh = shared_kv(h, kv_w)
    return h
```

```cpp
#include <hip/hip_runtime.h>
#include <hip/hip_bf16.h>
#include <cstdio>
#include <cstdint>

#define WAVE_TAB_LDS_OFF (131072 + 256)
__device__ __forceinline__ int wave_index() { const unsigned key = (unsigned)__builtin_amdgcn_s_getreg((5 << 11) | 4) & 63u;
    return __builtin_amdgcn_readfirstlane((int)((const __attribute__((address_space(3))) unsigned*)WAVE_TAB_LDS_OFF)[key]); }
__device__ __forceinline__ int tid_opaque(int wv) { unsigned z = 0u; asm volatile("" : "+v"(z));
    int t = wv * 64 + (int)__builtin_amdgcn_mbcnt_hi(~0u, __builtin_amdgcn_mbcnt_lo(~0u, z)); asm volatile("" : "+v"(t)); return t; }
__device__ __forceinline__ float dpp_add(float v, int ctrl_sel) {
    const int x = __builtin_bit_cast(int, v); int y;
    if (ctrl_sel == 0) y = __builtin_amdgcn_update_dpp(x, x, 0xB1, 0xF, 0xF, false);
    else if (ctrl_sel == 1) y = __builtin_amdgcn_update_dpp(x, x, 0x4E, 0xF, 0xF, false);
    else if (ctrl_sel == 2) y = __builtin_amdgcn_update_dpp(x, x, 0x141, 0xF, 0xF, false);
    else y = __builtin_amdgcn_update_dpp(x, x, 0x140, 0xF, 0xF, false);
    return v + __builtin_bit_cast(float, y);
}
__device__ __forceinline__ float row16_sum(float v) { v = dpp_add(v, 0); v = dpp_add(v, 1); v = dpp_add(v, 2); v = dpp_add(v, 3); return v; }
__device__ __forceinline__ float wave_sum(float v) {
    v = row16_sum(v); const int x = __builtin_bit_cast(int, v);
    const float a = __builtin_bit_cast(float, __builtin_amdgcn_readlane(x, 0)), b = __builtin_bit_cast(float, __builtin_amdgcn_readlane(x, 16)),
                c = __builtin_bit_cast(float, __builtin_amdgcn_readlane(x, 32)), d = __builtin_bit_cast(float, __builtin_amdgcn_readlane(x, 48));
    return (a + b) + (c + d);
}
__device__ __forceinline__ int shflx_i(int v, int m, int lane) { return __builtin_amdgcn_ds_bpermute((lane ^ m) << 2, v); }
__device__ __forceinline__ float shflx(float v, int m, int lane) { return __builtin_bit_cast(float, shflx_i(__builtin_bit_cast(int, v), m, lane)); }
namespace pg8 {
#define PG8_LAS __attribute__((address_space(3)))
#define PG8_GAS __attribute__((address_space(1)))
typedef unsigned short bf16_t;
typedef short bf16x8 __attribute__((ext_vector_type(8)));
typedef float f32x4 __attribute__((ext_vector_type(4)));
typedef float f32x2 __attribute__((ext_vector_type(2)));
typedef unsigned u32x4 __attribute__((ext_vector_type(4)));
constexpr int BM = 256, BK = 64, HALF = 128, HTB = HALF * BK * 2  , STAGE_BYTES = 8 * HTB, NXCD = 8, WGM = 8;

__host__ __device__ __forceinline__ int lds_byte(int r, int c) { const int st = (r >> 4) * 2 + (c >> 5), rr = r & 15, cc = c & 31, ob = rr * 64 + cc * 2; return st * 1024 + (ob ^ (((ob >> 9) & 1) << 5)); }
__host__ __device__ __forceinline__ void stage_rc(int b, int& R, int& C) { const int st = b / 1024, sb = b % 1024, swz = sb ^ (((sb >> 9) & 1) << 5); R = (st >> 1) * 16 + swz / 64; C = (st & 1) * 32 + (swz % 64) / 2; }
__host__ __device__ __forceinline__ int perm32(int rho) { const int n = rho >> 4, i = rho & 15; return 8 * (i >> 2) + 4 * n + (i & 3); }

struct Unit { int pm, pn, pb, orow, ex; };
struct Gemm { const bf16_t* A; const bf16_t* Bt; int K; int wv; };

struct StaticOrder {
    int nM, nN, nwg, G, c;
    __device__ __forceinline__ void init(int M, int N, int G_, int c_) { nM = M / BM; nN = N / BM; nwg = nM * nN; G = G_; c = c_; }
    __device__ __forceinline__ bool next(int i, Unit& u) const {
        const long L = (long)i * G + c; if (L >= nwg) return false;
        int wgid = (int)L; { const int q = nwg / NXCD, r = nwg % NXCD, xcd = wgid % NXCD, off = wgid / NXCD; wgid = (xcd < r ? xcd * (q + 1) : r * (q + 1) + (xcd - r) * q) + off; }
        const int nig = WGM * nN, gid = wgid / nig, fm = gid * WGM, gsz = (nM - fm) < WGM ? (nM - fm) : WGM;
        u.pm = fm + ((wgid % nig) % gsz); u.pn = (wgid % nig) / gsz; u.pb = u.pn; u.orow = u.pm * BM; u.ex = 0; return true;
    }
    __device__ __forceinline__ int arow(const Unit& u, int r) const { return u.pm * BM + r; }
};

template <bool GATHER> struct MoeOrder {
    int v, G, nt, npn, tpx;
    const PG8_LAS int* tile_e; const PG8_LAS int* rowtab;
    int k0, kend;
    __device__ __forceinline__ int unit_k(int i) const { return k0 + i * 32 + (v & 31); }
    __device__ __forceinline__ int tile_of(int i) const { const int k = unit_k(i); if (k < 0 || k >= kend) return nt; const int x = v >> 5, t = k / npn; return t < tpx ? x * tpx + t : nt; }
    __device__ __forceinline__ bool next(int i, Unit& u) const {
        const int rt = tile_of(i); if (rt >= nt) return false;
        const int pn = unit_k(i) % npn; const int e = __builtin_amdgcn_readfirstlane(tile_e[rt]);
        u.pm = i; u.pn = pn; u.pb = e * npn + pn; u.orow = rt * BM; u.ex = e; return true;
    }
    __device__ __forceinline__ int arow(const Unit& u, int r) const { if constexpr (GATHER) return rowtab[u.pm * BM + r]; else return u.orow + r; }
};

typedef int i32x4 __attribute__((ext_vector_type(4)));
typedef int i32x8 __attribute__((ext_vector_type(8)));
constexpr int F8_SCALE_W = 121, F8_SCALE_A = 125;
__device__ __forceinline__ i32x8 cat16(bf16x8 a, bf16x8 b) { const i32x4 x = __builtin_bit_cast(i32x4, a), y = __builtin_bit_cast(i32x4, b); return __builtin_shufflevector(x, y, 0, 1, 2, 3, 4, 5, 6, 7); }
__device__ __forceinline__ void mfma_f8(f32x4& c, const i32x8& a, const i32x8& b, int sa, int sb) {
    asm volatile("v_mfma_scale_f32_16x16x128_f8f6f4 %0, %1, %2, %0, %3, %4 op_sel_hi:[0,0,0]" : "+v"(c) : "v"(a), "v"(b), "v"(sa), "v"(sb)); }
__device__ __forceinline__ void mfma_f8_first(f32x4& c, const i32x8& a, const i32x8& b, int sa, int sb) {
    asm volatile("v_mfma_scale_f32_16x16x128_f8f6f4 %0, %1, %2, 0, %3, %4 op_sel_hi:[0,0,0]" : "=&v"(c) : "v"(a), "v"(b), "v"(sa), "v"(sb)); }
__device__ __forceinline__ unsigned cvt_pk_bf16(float lo, float hi) { typedef float f2 __attribute__((ext_vector_type(2))); typedef __bf16 b2 __attribute__((ext_vector_type(2))); f2 v = {lo, hi}; b2 b = __builtin_convertvector(v, b2); return __builtin_bit_cast(unsigned, b); }

__device__ __forceinline__ void store8(bf16_t* p, f32x4 v0, f32x4 v1) { u32x4 w; w.x = cvt_pk_bf16(v0[0], v0[1]); w.y = cvt_pk_bf16(v0[2], v0[3]); w.z = cvt_pk_bf16(v1[0], v1[1]); w.w = cvt_pk_bf16(v1[2], v1[3]); *(PG8_GAS u32x4*)p = w; }
__device__ __forceinline__ float silu_f(float x) { return x * __builtin_amdgcn_rcpf(1.0f + __builtin_amdgcn_exp2f(-1.4426950408889634f * x)); }

struct NoPre {};
struct EpiRetIn {
    static constexpr bool PERM = true, AFTER_DRAIN = false; typedef NoPre Pre;
    __device__ __forceinline__ void prefetch(Pre&, const Unit&, int, int, int, int) const {}
    __device__ __forceinline__ void touch(Pre&) const {}
    bf16_t* O; const float* cosT; const float* sinT;
    __device__ __forceinline__ void operator()(const f32x4 (&acc)[2][2][4][2], const Unit& u, int wr, int wc, int fr, int fq, const Pre&) const {
        const int row0 = u.orow + wr * 64 + fr, col0 = u.pn * BM + wc * 32 + 8 * fq;
        if (u.pn < 8) {
            const float sc = u.pn >= 4 ? 0.08838834764831845f : 1.0f; const int toff = 4 * (4 * wc + fq);
#pragma unroll
            for (int ai = 0; ai < 2; ++ai) { f32x4 cs[4], sn[4];
#pragma unroll
                for (int m = 0; m < 4; ++m) { const int pos = (row0 + ai * HALF + m * 16) & 8191; cs[m] = *(const PG8_GAS f32x4*)(cosT + pos * 64 + toff); sn[m] = *(const PG8_GAS f32x4*)(sinT + pos * 64 + toff); }
#pragma unroll
                for (int m = 0; m < 4; ++m) { bf16_t* rowp = O + (size_t)(row0 + ai * HALF + m * 16) * 6144 + col0; const f32x4 c_ = cs[m] * sc, s_ = sn[m] * sc;
#pragma unroll
                    for (int bj = 0; bj < 2; ++bj) { const f32x4 v0 = acc[ai][bj][m][0], v1 = acc[ai][bj][m][1]; store8(rowp + bj * HALF, v0 * c_ - v1 * s_, v1 * c_ + v0 * s_); } }
                asm volatile("" ::: "memory"); }
        } else if (u.pn >= 16) {
#pragma unroll
            for (int ai = 0; ai < 2; ++ai)
#pragma unroll
                for (int m = 0; m < 4; ++m) { bf16_t* rowp = O + (size_t)(row0 + ai * HALF + m * 16) * 6144 + col0;
#pragma unroll
                    for (int bj = 0; bj < 2; ++bj) { f32x4 v0 = acc[ai][bj][m][0], v1 = acc[ai][bj][m][1];
#pragma unroll
                        for (int j = 0; j < 4; ++j) { v0[j] = silu_f(v0[j]); v1[j] = silu_f(v1[j]); }
                        store8(rowp + bj * HALF, v0, v1); } }
        } else {
#pragma unroll
            for (int ai = 0; ai < 2; ++ai)
#pragma unroll
                for (int m = 0; m < 4; ++m) { bf16_t* rowp = O + (size_t)(row0 + ai * HALF + m * 16) * 6144 + col0;
#pragma unroll
                    for (int bj = 0; bj < 2; ++bj) store8(rowp + bj * HALF, acc[ai][bj][m][0], acc[ai][bj][m][1]); }
        }
    }
};
template <long offk, long offv, long offq> struct EpiDiffQK {
    static constexpr bool PERM = true, AFTER_DRAIN = false; typedef NoPre Pre;
    __device__ __forceinline__ void prefetch(Pre&, const Unit&, int, int, int, int) const {}
    __device__ __forceinline__ void touch(Pre&) const {}
    bf16_t* O; int pn_off; float qscale; const float* cosT; const float* sinT;
    __device__ __forceinline__ void operator()(const f32x4 (&acc)[2][2][4][2], const Unit& u, int wr, int wc, int fr, int fq, const Pre&) const {
        const int t = u.pn + pn_off; const int row0 = u.orow + wr * 64 + fr;
        const long boff = t < 4 ? offk : (t < 8 ? offv : offq); const bool rope = !(t >= 4 && t < 8); const float scale = t >= 8 ? qscale : 1.0f;
        bf16_t* base = O + boff;
        const int col0 = (t & 3) * BM + wc * 32 + 8 * fq; const bool dorope = rope && ((wc & 1) == 0) && fq < 2;
#pragma unroll
        for (int ai = 0; ai < 2; ++ai) { f32x4 cs[4], sn[4];
#pragma unroll
            for (int m = 0; m < 4; ++m) { cs[m] = (f32x4){1.f, 1.f, 1.f, 1.f}; sn[m] = (f32x4){0.f, 0.f, 0.f, 0.f};
                if (dorope) { const int pos = (row0 + ai * HALF + m * 16) & 8191; cs[m] = *(const PG8_GAS f32x4*)(cosT + pos * 8 + 4 * fq); sn[m] = *(const PG8_GAS f32x4*)(sinT + pos * 8 + 4 * fq); } }
#pragma unroll
            for (int m = 0; m < 4; ++m) { bf16_t* rowp = base + (size_t)(row0 + ai * HALF + m * 16) * 1024 + col0; const f32x4 c_ = cs[m] * scale, s_ = sn[m] * scale;
#pragma unroll
                for (int bj = 0; bj < 2; ++bj) { const f32x4 v0 = acc[ai][bj][m][0], v1 = acc[ai][bj][m][1]; store8(rowp + bj * HALF, v0 * c_ - v1 * s_, v1 * c_ + v0 * s_); } }
            asm volatile("" ::: "memory"); }
    }
};
struct EpiBf16Res {
    static constexpr bool PERM = true, AFTER_DRAIN = false; typedef NoPre Pre;
    __device__ __forceinline__ void prefetch(Pre&, const Unit&, int, int, int, int) const {}
    __device__ __forceinline__ void touch(Pre&) const {}
    const bf16_t* res; bf16_t* out; float alpha;
    __device__ __forceinline__ void operator()(const f32x4 (&acc)[2][2][4][2], const Unit& u, int wr, int wc, int fr, int fq, const Pre&) const {
        const int row0 = u.orow + wr * 64 + fr, col0 = u.pn * BM + wc * 32 + 8 * fq;
#pragma unroll
        for (int ai = 0; ai < 2; ++ai) { u32x4 rr[4][2];
#pragma unroll
            for (int m = 0; m < 4; ++m)
#pragma unroll
                for (int bj = 0; bj < 2; ++bj) rr[m][bj] = *(const PG8_GAS u32x4*)(res + (size_t)(row0 + ai * HALF + m * 16) * 1024 + col0 + bj * HALF);
#pragma unroll
            for (int m = 0; m < 4; ++m) { const size_t off = (size_t)(row0 + ai * HALF + m * 16) * 1024 + col0;
#pragma unroll
                for (int bj = 0; bj < 2; ++bj) { const u32x4 r = rr[m][bj];
                    const f32x4 r0 = {__builtin_bit_cast(float, r.x << 16), __builtin_bit_cast(float, r.x & 0xffff0000u), __builtin_bit_cast(float, r.y << 16), __builtin_bit_cast(float, r.y & 0xffff0000u)};
                    const f32x4 r1 = {__builtin_bit_cast(float, r.z << 16), __builtin_bit_cast(float, r.z & 0xffff0000u), __builtin_bit_cast(float, r.w << 16), __builtin_bit_cast(float, r.w & 0xffff0000u)};
                    store8(out + off + bj * HALF, acc[ai][bj][m][0] + r0 * alpha, acc[ai][bj][m][1] + r1 * alpha); } }
            asm volatile("" ::: "memory"); }
    }
};
template <bool F8> struct EpiSwiglu {
    static constexpr bool PERM = true, AFTER_DRAIN = false; struct Pre { f32x4 b[4]; };
    void* O; const float* bias;
    __device__ __forceinline__ void prefetch(Pre& P, const Unit& u, int wr, int wc, int fr, int fq) const { const float* bp = bias + (size_t)u.ex * 2048 + u.pn * HALF + wc * 32 + 8 * fq;
        const float* bq = bp + 1024;
        asm volatile("global_load_dwordx4 %0, %4, off\n\tglobal_load_dwordx4 %1, %4, off offset:16\n\tglobal_load_dwordx4 %2, %5, off\n\tglobal_load_dwordx4 %3, %5, off offset:16" : "=&v"(P.b[0]), "=&v"(P.b[1]), "=&v"(P.b[2]), "=&v"(P.b[3]) : "v"(bp), "v"(bq) : "memory"); }
    __device__ __forceinline__ void touch(Pre&) const {}
    __device__ __forceinline__ void operator()(const f32x4 (&acc)[2][2][4][2], const Unit& u, int wr, int wc, int fr, int fq, const Pre& P) const {
        const int row0 = u.orow + wr * 64 + fr, c0 = u.pn * HALF + wc * 32 + 8 * fq;
        const f32x4 bg0 = P.b[0], bg1 = P.b[1], bl0 = P.b[2], bl1 = P.b[3];
#pragma unroll
        for (int ai = 0; ai < 2; ++ai)
#pragma unroll
            for (int m = 0; m < 4; ++m) { const size_t eo = (size_t)(row0 + ai * HALF + m * 16) * 1024 + c0;
                f32x4 g0 = acc[ai][0][m][0] + bg0, g1 = acc[ai][0][m][1] + bg1, l0 = acc[ai][1][m][0] + bl0, l1 = acc[ai][1][m][1] + bl1;
                constexpr float OS = F8 ? 4.0f : 1.0f;
#pragma unroll
                for (int hh = 0; hh < 2; ++hh) { f32x4& gv = hh ? g1 : g0; const f32x4& lv = hh ? l1 : l0;
#pragma unroll
                    for (int j = 0; j < 4; j += 2) {
                        f32x2 g = {fminf(gv[j], 7.0f), fminf(gv[j + 1], 7.0f)}, l = {fminf(fmaxf(lv[j], -7.0f), 7.0f), fminf(fmaxf(lv[j + 1], -7.0f), 7.0f)};
                        const f32x2 t = g * (-1.702f * 1.4426950408889634f); f32x2 e; e.x = __builtin_amdgcn_exp2f(t.x); e.y = __builtin_amdgcn_exp2f(t.y);
                        const f32x2 d = e + 1.0f; f32x2 s; s.x = __builtin_amdgcn_rcpf(d.x); s.y = __builtin_amdgcn_rcpf(d.y);
                        const f32x2 h = (g * s) * (l * OS + OS); gv[j] = h.x; gv[j + 1] = h.y; } }
                if constexpr (F8) { int w0 = __builtin_amdgcn_cvt_pk_fp8_f32(g0[0], g0[1], 0, false); w0 = __builtin_amdgcn_cvt_pk_fp8_f32(g0[2], g0[3], w0, true);
                    int w1 = __builtin_amdgcn_cvt_pk_fp8_f32(g1[0], g1[1], 0, false); w1 = __builtin_amdgcn_cvt_pk_fp8_f32(g1[2], g1[3], w1, true);
                    typedef int i32x2_ __attribute__((ext_vector_type(2))); *(PG8_GAS i32x2_*)((unsigned char*)O + eo) = (i32x2_){w0, w1}; }
                else store8((bf16_t*)O + eo, g0, g1); }
    }
};
template <bool F8> struct EpiDown {
    static constexpr bool PERM = true, AFTER_DRAIN = false; struct Pre { f32x4 b[2][2]; };
    void* O; const float* bias;
    __device__ __forceinline__ void prefetch(Pre& P, const Unit& u, int wr, int wc, int fr, int fq) const { const float* bp = bias + (size_t)u.ex * 1024 + u.pn * BM + wc * 32 + 8 * fq;
        asm volatile("global_load_dwordx4 %0, %4, off\n\tglobal_load_dwordx4 %1, %4, off offset:16\n\tglobal_load_dwordx4 %2, %4, off offset:512\n\tglobal_load_dwordx4 %3, %4, off offset:528" : "=&v"(P.b[0][0]), "=&v"(P.b[0][1]), "=&v"(P.b[1][0]), "=&v"(P.b[1][1]) : "v"(bp) : "memory"); }
    __device__ __forceinline__ void touch(Pre&) const {}
    __device__ __forceinline__ void operator()(const f32x4 (&acc)[2][2][4][2], const Unit& u, int wr, int wc, int fr, int fq, const Pre& P) const {
        const int row0 = u.orow + wr * 64 + fr, col0 = u.pn * BM + wc * 32 + 8 * fq;
        const f32x4 (&bv)[2][2] = P.b;
        if constexpr (F8) {
            typedef int i32x4_ __attribute__((ext_vector_type(4))); const bool odd = fq & 1;
#pragma unroll
            for (int ai = 0; ai < 2; ++ai)
#pragma unroll
                for (int bj = 0; bj < 2; ++bj)
#pragma unroll
                    for (int mp = 0; mp < 4; mp += 2) { int w[2][2];
#pragma unroll
                        for (int q = 0; q < 2; ++q) { const f32x4 v0 = acc[ai][bj][mp + q][0] + bv[bj][0], v1 = acc[ai][bj][mp + q][1] + bv[bj][1];
                            int t0 = __builtin_amdgcn_cvt_pk_fp8_f32(v0[0] * 32.0f, v0[1] * 32.0f, 0, false); t0 = __builtin_amdgcn_cvt_pk_fp8_f32(v0[2] * 32.0f, v0[3] * 32.0f, t0, true);
                            int t1 = __builtin_amdgcn_cvt_pk_fp8_f32(v1[0] * 32.0f, v1[1] * 32.0f, 0, false); t1 = __builtin_amdgcn_cvt_pk_fp8_f32(v1[2] * 32.0f, v1[3] * 32.0f, t1, true);
                            w[q][0] = t0; w[q][1] = t1; }
                        const int s0 = odd ? w[0][0] : w[1][0], s1 = odd ? w[0][1] : w[1][1];
                        const int ln_ = fr + 16 * fq; const int r0 = shflx_i(s0, 16, ln_), r1 = shflx_i(s1, 16, ln_);
                        const i32x4_ o = odd ? (i32x4_){r0, r1, w[1][0], w[1][1]} : (i32x4_){w[0][0], w[0][1], r0, r1};
                        const size_t eo = (size_t)(row0 + ai * HALF + (mp + (odd ? 1 : 0)) * 16) * 1024 + (col0 - (odd ? 8 : 0)) + bj * HALF;
                        *(PG8_GAS i32x4_*)((unsigned char*)O + eo) = o; }
        } else {
#pragma unroll
            for (int ai = 0; ai < 2; ++ai)
#pragma unroll
                for (int m = 0; m < 4; ++m) { const size_t eo = (size_t)(row0 + ai * HALF + m * 16) * 1024 + col0;
#pragma unroll
                    for (int bj = 0; bj < 2; ++bj) store8((bf16_t*)O + eo + bj * HALF, acc[ai][bj][m][0] + bv[bj][0], acc[ai][bj][m][1] + bv[bj][1]); }
        }
    }
};

template <class Epi, class Sched, bool ALIGN_EPI = false, bool SP2 = false, bool F8 = false, int KREP = 1>
__device__ __forceinline__ void gemm_phase(PG8_LAS unsigned char* lds, const Gemm g, const Sched& S, const Epi& E) {
    const int tid = tid_opaque(g.wv), wid = g.wv, lane = tid & 63, wr = wid >> 2, wc = wid & 3, fr = lane & 15, fq = lane >> 4;
    const int K = g.K, nt = K / BK;
    unsigned voffB[2];
#pragma unroll
    for (int i = 0; i < 2; ++i) { int R, C; stage_rc(tid * 16 + i * 8192, R, C); const int Rb = Epi::PERM ? ((R & ~31) + perm32(R & 31)) : R;
        voffB[i] = (unsigned)(Rb * K + C) * 2u; }
    const unsigned rowb = (unsigned)K * 2u;
    const size_t kstep = (size_t)(BK * 2);
    const size_t hstep = (size_t)HALF * K * 2;
    const size_t tstep = 2 * hstep;
    const unsigned ldsw = (unsigned)wid * 1024u;
    const int aoff = lds_byte(wr * 64 + fr, fq * 8), boff = lds_byte(wc * 32 + fr, fq * 8);
    const char* Ab = (const char*)g.A;
    int sc_w = (KREP == 1) ? (F8_SCALE_W + F8_SCALE_A) / 2 : F8_SCALE_W, sc_a = (KREP == 1) ? (F8_SCALE_W + F8_SCALE_A) / 2 : F8_SCALE_A - 1;
#define PG8_SA(b, h) (((b) * 2 + (h)) * HTB)
#define PG8_SB(b, h) ((4 + (b) * 2 + (h)) * HTB)
#define PG8_STAGE(bufoff, gbase, voff) do { _Pragma("unroll") for (int _i = 0; _i < 2; ++_i) \
        __builtin_amdgcn_global_load_lds((const unsigned*)((const char*)(gbase) + (voff)[_i]), (PG8_LAS unsigned*)(lds + (bufoff) + ldsw + _i * 8192), 16, 0, 0); } while (0)
#define PG8_STAGE_A(bufoff, kb, v0_, v1_) do { \
        __builtin_amdgcn_global_load_lds((const unsigned*)(Ab + (kb) + (v0_)), (PG8_LAS unsigned*)(lds + (bufoff) + ldsw), 16, 0, 0); \
        __builtin_amdgcn_global_load_lds((const unsigned*)(Ab + (kb) + (v1_)), (PG8_LAS unsigned*)(lds + (bufoff) + ldsw + 8192), 16, 0, 0); } while (0)
#define PG8_LDA(dst, b, h) do { _Pragma("unroll") for (int m = 0; m < 4; ++m) _Pragma("unroll") for (int k = 0; k < 2; ++k) dst[m][k] = *(const PG8_LAS bf16x8*)(lds + PG8_SA(b, h) + aoff + m * 2048 + k * 1024); } while (0)
#define PG8_LDB(dst, b, h) do { _Pragma("unroll") for (int n = 0; n < 2; ++n) _Pragma("unroll") for (int k = 0; k < 2; ++k) dst[n][k] = *(const PG8_LAS bf16x8*)(lds + PG8_SB(b, h) + boff + n * 2048 + k * 1024); } while (0)
#define PG8_MMA(ai, bj, At, Bt) do { __builtin_amdgcn_s_setprio(1); _Pragma("unroll") for (int m = 0; m < 4; ++m) _Pragma("unroll") for (int n = 0; n < 2; ++n) { \
        if constexpr (F8) mfma_f8(acc[ai][bj][m][n], cat16(Bt[n][0], Bt[n][1]), cat16(At[m][0], At[m][1]), sc_w, sc_a); \
        else { _Pragma("unroll") for (int k = 0; k < 2; ++k) acc[ai][bj][m][n] = __builtin_amdgcn_mfma_f32_16x16x32_bf16(Bt[n][k], At[m][k], acc[ai][bj][m][n], 0, 0, 0); } } __builtin_amdgcn_s_setprio(0); } while (0)
#define PG8_MMA_FIRST(ai, bj, At, Bt) do { if (!F8 || tt != 0) { PG8_MMA(ai, bj, At, Bt); } else { __builtin_amdgcn_s_setprio(1); _Pragma("unroll") for (int m = 0; m < 4; ++m) _Pragma("unroll") for (int n = 0; n < 2; ++n) { \
        if constexpr (F8) mfma_f8_first(acc[ai][bj][m][n], cat16(Bt[n][0], Bt[n][1]), cat16(At[m][0], At[m][1]), sc_w, sc_a); \
        else { acc[ai][bj][m][n] = __builtin_amdgcn_mfma_f32_16x16x32_bf16(Bt[n][0], At[m][0], (f32x4){0.f, 0.f, 0.f, 0.f}, 0, 0, 0); acc[ai][bj][m][n] = __builtin_amdgcn_mfma_f32_16x16x32_bf16(Bt[n][1], At[m][1], acc[ai][bj][m][n], 0, 0, 0); } } __builtin_amdgcn_s_setprio(0); } } while (0)
#define PG8_WAIT_V(n) asm volatile("s_waitcnt vmcnt(" #n ")" ::: "memory")
#define PG8_WAIT_L(n) asm volatile("s_waitcnt lgkmcnt(" #n ")" ::: "memory")
#define PG8_BAR __builtin_amdgcn_s_barrier()
#define PG8_SCHED __builtin_amdgcn_sched_barrier(0)
#define PG8_ROWS(u_, v_) do { _Pragma("unroll") for (int _i = 0; _i < 2; ++_i) { int _R, _C; stage_rc(tid * 16 + _i * 8192, _R, _C); _Pragma("unroll") for (int _h = 0; _h < 2; ++_h) (v_)[_h][_i] = (unsigned)S.arow((u_), _h * HALF + _R) * rowb + (unsigned)_C * 2u; } } while (0)
    Unit cur, nxt; int ui = 0;
    if (!S.next(0, cur)) return;
    f32x4 acc[2][2][4][2];
#pragma unroll
    for (int a = 0; a < 2; ++a)
#pragma unroll
        for (int b = 0; b < 2; ++b)
#pragma unroll
            for (int m = 0; m < 4; ++m)
#pragma unroll
                for (int n = 0; n < 2; ++n) acc[a][b][m][n] = (f32x4){0.f, 0.f, 0.f, 0.f};
    bf16x8 At[4][2], B0[2][2], B1[2][2];
    unsigned va[2][2];
    PG8_ROWS(cur, va);
    const char* cB = (const char*)g.Bt + (size_t)cur.pb * tstep;
    typename Epi::Pre pre;
    if constexpr (SP2) {
        PG8_STAGE(PG8_SB(0, 0), cB, voffB); PG8_STAGE(PG8_SB(0, 1), cB + hstep, voffB); PG8_STAGE_A(PG8_SA(0, 0), 0, va[0][0], va[0][1]); PG8_STAGE_A(PG8_SA(0, 1), 0, va[1][0], va[1][1]);
        if (wr == 1) PG8_BAR;
        PG8_WAIT_V(2); PG8_BAR;
        PG8_STAGE(PG8_SB(1, 0), cB + kstep, voffB); PG8_STAGE_A(PG8_SA(1, 0), kstep, va[0][0], va[0][1]); PG8_STAGE(PG8_SB(1, 1), cB + hstep + kstep, voffB);
        PG8_WAIT_V(6); PG8_BAR;
    } else {
        PG8_STAGE(PG8_SB(0, 0), cB, voffB); PG8_STAGE_A(PG8_SA(0, 0), 0, va[0][0], va[0][1]); PG8_STAGE(PG8_SB(0, 1), cB + hstep, voffB); PG8_STAGE_A(PG8_SA(0, 1), 0, va[1][0], va[1][1]);
        if (wr == 1) PG8_BAR;
        PG8_WAIT_V(4); PG8_BAR;
        PG8_STAGE(PG8_SB(1, 0), cB + kstep, voffB); PG8_STAGE_A(PG8_SA(1, 0), kstep, va[0][0], va[0][1]); PG8_STAGE(PG8_SB(1, 1), cB + hstep + kstep, voffB);
        PG8_WAIT_V(6); PG8_BAR;
    }
    for (;;) {
        const bool has_next = S.next(ui + 1, nxt);
        const char* nB = has_next ? (const char*)g.Bt + (size_t)nxt.pb * tstep : cB;
        for (int tt = 0; tt < nt * KREP; tt += 2) {
            const bool last = (tt == nt * KREP - 2); const int t = (KREP == 1) ? tt : (tt & (nt - 1)), t2 = (KREP == 1) ? tt + 2 : ((tt + 2) & (nt - 1));
            const size_t k1 = (size_t)(t + 1) * kstep;
            const size_t k2 = last ? 0 : (size_t)t2 * kstep, k3 = k2 + kstep;
            const char* b2 = last ? nB : cB + (size_t)t2 * kstep; const char* b3 = b2 + kstep;
            const unsigned a1_0 = va[1][0], a1_1 = va[1][1];
            if (last) E.prefetch(pre, cur, wr, wc, fr, fq);
            if (last && has_next) { PG8_ROWS(nxt, va); PG8_SCHED; }
            if constexpr (SP2) {
            PG8_LDB(B0, 0, 0); PG8_LDB(B1, 0, 1); PG8_SCHED; PG8_LDA(At, 0, 0); PG8_STAGE_A(PG8_SA(1, 1), k1, a1_0, a1_1);
            PG8_WAIT_V(8); PG8_WAIT_L(0); PG8_BAR; PG8_MMA_FIRST(0, 0, At, B0); PG8_MMA_FIRST(0, 1, At, B1); PG8_BAR; PG8_SCHED;
            PG8_LDA(At, 0, 1); PG8_STAGE(PG8_SB(0, 0), b2, voffB); PG8_STAGE(PG8_SB(0, 1), b2 + hstep, voffB); PG8_STAGE_A(PG8_SA(0, 0), k2, va[0][0], va[0][1]);
            PG8_WAIT_V(8); PG8_WAIT_L(0); PG8_BAR; PG8_MMA_FIRST(1, 0, At, B0); PG8_MMA_FIRST(1, 1, At, B1); PG8_BAR; PG8_SCHED;
            PG8_LDB(B0, 1, 0); PG8_LDB(B1, 1, 1); PG8_SCHED; PG8_LDA(At, 1, 0); PG8_STAGE_A(PG8_SA(0, 1), k2, va[1][0], va[1][1]);
            PG8_WAIT_V(8); PG8_WAIT_L(0); PG8_BAR; PG8_MMA(0, 0, At, B0); PG8_MMA(0, 1, At, B1); PG8_BAR; PG8_SCHED;
            PG8_LDA(At, 1, 1); PG8_STAGE(PG8_SB(1, 0), b3, voffB); PG8_STAGE(PG8_SB(1, 1), b3 + hstep, voffB); PG8_STAGE_A(PG8_SA(1, 0), k3, va[0][0], va[0][1]);
            PG8_WAIT_V(8); PG8_WAIT_L(0); PG8_BAR; PG8_MMA(1, 0, At, B0); PG8_MMA(1, 1, At, B1); PG8_BAR; PG8_SCHED;
            } else {
            PG8_LDB(B0, 0, 0); PG8_SCHED; PG8_LDA(At, 0, 0); PG8_STAGE_A(PG8_SA(1, 1), k1, a1_0, a1_1);
            PG8_WAIT_L(8); PG8_BAR; PG8_WAIT_L(0); PG8_MMA(0, 0, At, B0); PG8_BAR; PG8_SCHED;
            PG8_LDB(B1, 0, 1); PG8_STAGE(PG8_SB(0, 0), b2, voffB);
            PG8_BAR; PG8_WAIT_L(0); PG8_MMA(0, 1, At, B1); PG8_BAR;
            PG8_LDA(At, 0, 1); PG8_STAGE_A(PG8_SA(0, 0), k2, va[0][0], va[0][1]);
            PG8_BAR; PG8_WAIT_L(0); PG8_MMA(1, 0, At, B0); PG8_BAR; PG8_SCHED;
            PG8_STAGE(PG8_SB(0, 1), b2 + hstep, voffB);
            PG8_WAIT_V(6); PG8_BAR; PG8_MMA(1, 1, At, B1); PG8_BAR;
            PG8_LDB(B0, 1, 0); PG8_SCHED; PG8_LDA(At, 1, 0); PG8_STAGE_A(PG8_SA(0, 1), k2, va[1][0], va[1][1]);
            PG8_WAIT_L(8); PG8_BAR; PG8_WAIT_L(0); PG8_MMA(0, 0, At, B0); PG8_BAR; PG8_SCHED;
            PG8_LDB(B1, 1, 1); PG8_STAGE(PG8_SB(1, 0), b3, voffB);
            PG8_BAR; PG8_WAIT_L(0); PG8_MMA(0, 1, At, B1); PG8_BAR;
            PG8_LDA(At, 1, 1); PG8_STAGE_A(PG8_SA(1, 0), k3, va[0][0], va[0][1]);
            PG8_BAR; PG8_WAIT_L(0); PG8_MMA(1, 0, At, B0); PG8_BAR; PG8_SCHED;
            PG8_STAGE(PG8_SB(1, 1), b3 + hstep, voffB);
            PG8_WAIT_V(6); PG8_BAR; PG8_MMA(1, 1, At, B1); PG8_BAR;
            }
            if (last) E.touch(pre);
        }
        if constexpr (ALIGN_EPI) { if (wr == 0) PG8_BAR; }
        if constexpr (F8) asm volatile("s_nop 15\n\ts_nop 15" ::: "memory");
        E(acc, cur, wr, wc, fr, fq, pre);
#if defined(EREP_PROBE)
        if constexpr (F8) { asm volatile("" ::: "memory");
#pragma unroll
            for (int a = 0; a < 2; ++a)
#pragma unroll
                for (int b = 0; b < 2; ++b)
#pragma unroll
                    for (int m = 0; m < 4; ++m)
#pragma unroll
                        for (int n = 0; n < 2; ++n) asm volatile("" : "+v"(acc[a][b][m][n]));
            E(acc, cur, wr, wc, fr, fq, pre); }
#endif
        if (!has_next) break;
#pragma unroll
        for (int a = 0; a < 2; ++a)
#pragma unroll
            for (int b = 0; b < 2; ++b)
#pragma unroll
                for (int m = 0; m < 4; ++m)
#pragma unroll
                    for (int n = 0; n < 2; ++n) { if constexpr (F8) asm volatile("" : "=v"(acc[a][b][m][n])); else acc[a][b][m][n] = (f32x4){0.f, 0.f, 0.f, 0.f}; }
        cur = nxt; cB = nB; ++ui;
        if constexpr (ALIGN_EPI) { if (wr == 1) PG8_BAR; }
    }
    PG8_WAIT_V(0);
    if constexpr (!ALIGN_EPI) { if (wr == 0) PG8_BAR; }
    PG8_BAR;
#undef PG8_SA
#undef PG8_SB
#undef PG8_STAGE
#undef PG8_STAGE_A
#undef PG8_LDA
#undef PG8_LDB
#undef PG8_MMA
#undef PG8_MMA_FIRST
#undef PG8_WAIT_V
#undef PG8_WAIT_L
#undef PG8_BAR
#undef PG8_SCHED
#undef PG8_ROWS
}
}
namespace attn_body {
using bf16=__hip_bfloat16;
using bf16x8=__attribute__((ext_vector_type(8)))short;
using s16x4=__attribute__((ext_vector_type(4)))short;
using f32x16=__attribute__((ext_vector_type(16)))float;
using u32x4=__attribute__((ext_vector_type(4)))unsigned;
constexpr int BATCH=4,NHEAD=16,SEQ=8192,D=64,DM=NHEAD*D,OPITCH=2048;
constexpr int NW=8,QBLK=32,QB=QBLK*NW,KVBLK=64,NQB=SEQ/QB;
constexpr int ATTN_PITCH=DM, ATTN_UNIT_ROWS=QB;
__device__ __forceinline__ int crow(int r,int hi){return (r&3)+8*(r>>2)+4*hi;}
#define SBAR() __builtin_amdgcn_sched_barrier(0)
__device__ __forceinline__ void cmask(f32x16&p0,f32x16&p1,int jb,int qrel,int hi){
  const float NEG=-INFINITY; int kb=64*jb+4*hi;
  #pragma unroll
  for(int r=0;r<16;++r){int kv=kb+(r&3)+8*(r>>2); if(kv>qrel)p0[r]=NEG; if(kv+32>qrel)p1[r]=NEG;}
}

constexpr int NSLOT=3, SLOTB=8192, SLOTV=2*SLOTB;
constexpr int LDS_K=0, LDS_V=NSLOT*SLOTB, LDS_WS=LDS_V+NSLOT*SLOTV, LDS_OST=LDS_WS+NW*64*4, LDS_BYTES=LDS_OST+NW*4096;
constexpr float C2=0.125f*1.4426950408889634f;
__device__ __forceinline__ void glds16(const void*gsrc,unsigned lds_dst){unsigned keep;
  asm volatile("s_mov_b32 %0, m0\n\ts_mov_b32 m0, %2\n\ts_nop 0\n\tglobal_load_lds_dwordx4 %1, off\n\ts_mov_b32 m0, %0":"=&s"(keep):"v"(gsrc),"s"(lds_dst):"memory");}
__device__ __forceinline__ float max3f(float a,float b,float c){float r;asm("v_max3_f32 %0, %1, %2, %3":"=v"(r):"v"(a),"v"(b),"v"(c));return r;}
__device__ __forceinline__ float max2f(float a,float b){float r;asm("v_max_f32_e32 %0, %1, %2":"=v"(r):"v"(a),"v"(b));return r;}
__device__ __forceinline__ float fadd_s(float a,float b){float r;asm("v_add_f32_e32 %0, %1, %2":"=v"(r):"v"(a),"v"(b));return r;}
__device__ __forceinline__ float fsub_s(float a,float b){float r;asm("v_sub_f32_e32 %0, %1, %2":"=v"(r):"v"(a),"v"(b));return r;}
typedef float f32x2_t __attribute__((ext_vector_type(2))); typedef __bf16 bf16x2_t __attribute__((ext_vector_type(2)));
__device__ __forceinline__ unsigned cvtpk_s(float lo,float hi){f32x2_t v={lo,hi};bf16x2_t b=__builtin_convertvector(v,bf16x2_t);return __builtin_bit_cast(unsigned,b);}
#define WAIT_BAR(N) asm volatile("s_waitcnt vmcnt(" #N ") lgkmcnt(0)\n\ts_barrier":::"memory")

__device__ __forceinline__ void qkt(f32x16&p0,f32x16&p1,const __attribute__((address_space(3))) char*Kslot,const bf16x8*qr,const f32x16&negm,int r32,int hi){
  const __attribute__((address_space(3))) char*kb=Kslot+hi*1024+r32*16;
  #pragma unroll
  for(int d0=0;d0<4;++d0){
    const bf16x8 b0=*(const __attribute__((address_space(3))) bf16x8*)(kb+d0*2048);
    const bf16x8 b1=*(const __attribute__((address_space(3))) bf16x8*)(kb+d0*2048+512);
    if(d0==0){p0=__builtin_amdgcn_mfma_f32_32x32x16_bf16(b0,qr[0],negm,0,0,0);p1=__builtin_amdgcn_mfma_f32_32x32x16_bf16(b1,qr[0],negm,0,0,0);}
    else{p0=__builtin_amdgcn_mfma_f32_32x32x16_bf16(b0,qr[d0],p0,0,0,0);p1=__builtin_amdgcn_mfma_f32_32x32x16_bf16(b1,qr[d0],p1,0,0,0);}}
}
typedef __attribute__((address_space(3))) const char* lds_cptr;
typedef short v4i16_t __attribute__((ext_vector_type(4)));
__device__ __forceinline__ void kload8(bf16x8*kf,lds_cptr kp){
  kf[0]=*(const __attribute__((address_space(3))) bf16x8*)(kp);      kf[1]=*(const __attribute__((address_space(3))) bf16x8*)(kp+512);
  kf[2]=*(const __attribute__((address_space(3))) bf16x8*)(kp+2048); kf[3]=*(const __attribute__((address_space(3))) bf16x8*)(kp+2560);
  kf[4]=*(const __attribute__((address_space(3))) bf16x8*)(kp+4096); kf[5]=*(const __attribute__((address_space(3))) bf16x8*)(kp+4608);
  kf[6]=*(const __attribute__((address_space(3))) bf16x8*)(kp+6144); kf[7]=*(const __attribute__((address_space(3))) bf16x8*)(kp+6656);
}
__device__ __forceinline__ void kload2(bf16x8*kf,lds_cptr kp,int j){ kf[2*j]=*(const __attribute__((address_space(3))) bf16x8*)(kp+j*2048); kf[2*j+1]=*(const __attribute__((address_space(3))) bf16x8*)(kp+j*2048+512); }
__device__ __forceinline__ s16x4 vtr(lds_cptr p){ return __builtin_bit_cast(s16x4,__builtin_amdgcn_ds_read_tr16_b64_v4i16((__attribute__((address_space(3))) v4i16_t*)p)); }
__device__ __forceinline__ float rowmax(const f32x16&p0,const f32x16&p1){
  float a=max3f(p0[0],p0[1],p1[0]),b=max3f(p0[2],p0[3],p1[1]);a=max3f(a,p1[2],p1[3]);
  #pragma unroll
  for(int r=4;r<16;r+=4){a=max3f(a,p0[r],p0[r+1]);b=max3f(b,p0[r+2],p0[r+3]);a=max3f(a,p1[r],p1[r+1]);b=max3f(b,p1[r+2],p1[r+3]);}
  const float m=max2f(a,b);
  auto rr=__builtin_amdgcn_permlane32_swap(__float_as_uint(m),__float_as_uint(m),false,false);
  return max2f(__uint_as_float(rr[0]),__uint_as_float(rr[1]));
}
__device__ __forceinline__ void pv(f32x16*o,int vb,bf16x8 pa0,bf16x8 pa1,bf16x8 pa2,bf16x8 pa3){
  #pragma unroll
  for(int d0=0;d0<4;++d0){s16x4 lo[4],hi[4];
    #pragma unroll
    for(int ks=0;ks<4;++ks){
      asm volatile("ds_read_b64_tr_b16 %0,%1 offset:%c2":"=&v"(lo[ks]):"v"(vb),"i"(d0*4096+ks*1024):"memory");
      asm volatile("ds_read_b64_tr_b16 %0,%1 offset:%c2":"=&v"(hi[ks]):"v"(vb),"i"(d0*4096+ks*1024+512):"memory");}
    asm volatile("s_waitcnt lgkmcnt(0)":::"memory");SBAR();
    #define PK(k) (bf16x8){lo[k][0],lo[k][1],lo[k][2],lo[k][3],hi[k][0],hi[k][1],hi[k][2],hi[k][3]}
    o[d0]=__builtin_amdgcn_mfma_f32_32x32x16_bf16(pa0,PK(0),o[d0],0,0,0);
    o[d0]=__builtin_amdgcn_mfma_f32_32x32x16_bf16(pa1,PK(1),o[d0],0,0,0);
    o[d0]=__builtin_amdgcn_mfma_f32_32x32x16_bf16(pa2,PK(2),o[d0],0,0,0);
    o[d0]=__builtin_amdgcn_mfma_f32_32x32x16_bf16(pa3,PK(3),o[d0],0,0,0);
    #undef PK
  }
}

#ifndef ATTN_STORE16
#define ATTN_STORE16(p,v) (*(__attribute__((address_space(1))) u32x4*)(p)=(v))
#endif
template<int THRL> __device__ __forceinline__ void attn_unit(int wv,int b,int h,int hv,int ocol,int qb,const bf16*Q,const bf16*__restrict__ K,const bf16*__restrict__ V,bf16*O,char*shm,bf16*OD,float lam,const float*subg,float lam_init){
  const int tid=tid_opaque(wv),lane=tid&63,r32=lane&31,hi=lane>>5; const int wid=wv;
  const long rowbase=(long)b*SEQ; const int q0=qb*QB;
  const bf16*Qw=Q+(rowbase+q0+wid*QBLK)*DM+h*D;
  const bf16*Kh=K+rowbase*DM+h*D,*Vh=V+rowbase*DM+hv*D;
  const unsigned lds0=(unsigned)(uintptr_t)shm;
  __attribute__((address_space(3))) float*wsf=(__attribute__((address_space(3))) float*)(shm+LDS_WS)+wid*64;
  const bf16*ksrc=Kh+(long)lane*DM+wid*8;
  const bf16*vsrc=Vh+(long)(16*(wid&3)+(lane>>2))*DM+(wid>>2)*32+(lane&3)*8;
  const unsigned kdst=lds0+LDS_K+wid*1024, vdst=lds0+LDS_V+wid*1024;
  #define DMA_K(t,slot) glds16(ksrc+(long)(t)*KVBLK*DM,(unsigned)__builtin_amdgcn_readfirstlane(kdst+(slot)))
  #define DMA_V(t,slot) do{ glds16(vsrc+(long)(t)*KVBLK*DM,(unsigned)__builtin_amdgcn_readfirstlane(vdst+2*(slot))); glds16(vsrc+(long)(t)*KVBLK*DM+64,(unsigned)__builtin_amdgcn_readfirstlane(vdst+2*(slot)+8192)); }while(0)
  const __attribute__((address_space(3))) char*Kbase=(const __attribute__((address_space(3))) char*)(shm+LDS_K); bf16x8 kf[8];
  const lds_cptr shm3=(lds_cptr)shm; const lds_cptr kp0=shm3+LDS_K+hi*1024+r32*16; const lds_cptr vp0=shm3+LDS_V+((lane>>4)&1)*32+(lane&3)*8+(4*hi+((lane&15)>>2))*64;
  const int NT=(q0+QB)/KVBLK;
  DMA_K(0,0);DMA_V(0,0);DMA_K(1,SLOTB);
  bf16x8 qr[4];
  #pragma unroll
  for(int d0=0;d0<4;++d0)qr[d0]=*(const __attribute__((address_space(1))) bf16x8*)(&Qw[(long)r32*DM+d0*16+hi*8]);
  float mhat=0.f,l_reg=0.f;f32x16 o[4];o[0]=f32x16{};o[1]=f32x16{};o[2]=f32x16{};o[3]=f32x16{};f32x16 negm=f32x16{};asm volatile("":"+v"(negm));
  const int qrel=wid*QBLK+r32;
  #define CMASK(P0,P1,t) do{int jb_=(t)-(NT-4); if(jb_>=0)cmask(P0,P1,jb_,qrel,hi);}while(0)
  bool resc=false;
  #define START(P0,P1) do{ const float rm=rowmax(P0,P1); resc=false; \
    { const float dl=rm; mhat=fadd_s(mhat,dl); \
      _Pragma("unroll") for(int r=0;r<16;++r){P0[r]=fsub_s(P0[r],dl);P1[r]=fsub_s(P1[r],dl);} \
      _Pragma("unroll") for(int r=0;r<16;++r)negm[r]=-mhat; asm volatile("":"+v"(negm)); } \
    _Pragma("unroll") for(int r=0;r<16;++r)P0[r]=__builtin_amdgcn_exp2f(P0[r]); }while(0)
  #define RESC() do{ if(resc){ asm volatile("s_waitcnt lgkmcnt(0)":::"memory"); \
      _Pragma("unroll") for(int d_=0;d_<4;++d_) _Pragma("unroll") for(int r=0;r<16;++r)o[d_][r]*=wsf[crow(r,hi)]; } }while(0)
  f32x16 pA0,pA1,pB0,pB1;
  int sl_prev=0,sl_cur=0,sl_next=SLOTB;
  #define ROT() do{sl_prev=sl_cur;sl_cur=sl_next;sl_next=(sl_next==(NSLOT-1)*SLOTB)?0:sl_next+SLOTB;}while(0)
  DMA_K(2,2*SLOTB);
  WAIT_BAR(3);
  qkt(pA0,pA1,Kbase,qr,negm,r32,hi);asm volatile("s_nop 15\n\ts_nop 7":"+v"(pA0),"+v"(pA1));CMASK(pA0,pA1,0);
  START(pA0,pA1);
  _Pragma("unroll") for(int r=0;r<16;++r)pA1[r]=__builtin_amdgcn_exp2f(pA1[r]);
  WAIT_BAR(0);
  DMA_K(3,0);DMA_V(1,SLOTB);
  ROT();
  kload8(kf,kp0+sl_cur);
  WAIT_BAR(3);
  s16x4 vlo[8],vhi[8]; u32x4 pw0,pw1,pw2,pw3;
  #define PKW(P,B) cvtpk_s(P[B],P[B+1])
  #define PAF(k) __builtin_bit_cast(bf16x8,pw##k)
  #define VFR(i) (bf16x8){vlo[i][0],vlo[i][1],vlo[i][2],vlo[i][3],vhi[i][0],vhi[i][1],vhi[i][2],vhi[i][3]}
  #define PIN(x) asm volatile("":"+v"(x))
  #define MX3(a,b,c) __builtin_fmaxf(__builtin_fmaxf((a),(b)),(c))
  #define GAPA(MF,A0,A1,A2,A3,W0,W1,PW) do{ MF; sacc+=A0; sacc+=A1; sacc+=A2; sacc+=A3; PIN(sacc); W0; W1; PIN(PW); SBAR(); }while(0)
  #define EX(v) __builtin_amdgcn_exp2f(v)
  #define GAPB(MF,X,B) do{ MF; X[B]=EX(X[B]); X[B+1]=EX(X[B+1]); PIN(X); SBAR(); }while(0)
  #define VRD2(i) do{ vlo[i]=vtr(vp_+((((i)>>2)+2)*4096+((i)&3)*1024)); vhi[i]=vtr(vp_+((((i)>>2)+2)*4096+((i)&3)*1024+512)); SBAR(); }while(0)
  #define VRD(i) do{ vlo[i]=vtr(vp_+(((i)>>2)*4096+((i)&3)*1024)); vhi[i]=vtr(vp_+(((i)>>2)*4096+((i)&3)*1024+512)); }while(0)
  #define KRD(G,j) do{ if(G){ kload2(kf,kp0+sl_next,j); SBAR(); } }while(0)
  #define STEP(C0,C1,P0,P1,t,GK,GV,GL) do{ SBAR(); \
    const lds_cptr vp_=vp0+2*sl_prev; \
    VRD(0); SBAR(); float sacc=(P0[0]+P0[1]); \
    GAPA(C0=__builtin_amdgcn_mfma_f32_32x32x16_bf16(kf[0],qr[0],negm,0,0,0), P0[2],P0[3],P0[4],P0[5],     pw0[0]=PKW(P0,0), pw0[1]=PKW(P0,2), pw0); \
    VRD(4); SBAR(); GAPA(C1=__builtin_amdgcn_mfma_f32_32x32x16_bf16(kf[1],qr[0],negm,0,0,0), P0[6],P0[7],P0[8],P0[9],     pw0[2]=PKW(P0,4), pw0[3]=PKW(P0,6), pw0); \
    VRD(1); SBAR(); GAPA(C0=__builtin_amdgcn_mfma_f32_32x32x16_bf16(kf[2],qr[1],C0,0,0,0),   P0[10],P0[11],P0[12],P0[13], pw1[0]=PKW(P0,8), pw1[1]=PKW(P0,10), pw1); \
    VRD(5); SBAR(); GAPA(C1=__builtin_amdgcn_mfma_f32_32x32x16_bf16(kf[3],qr[1],C1,0,0,0),   P0[14],P0[15],P1[0],P1[1],   pw1[2]=PKW(P0,12),pw1[3]=PKW(P0,14), pw1); \
    VRD(2); SBAR(); GAPA(C0=__builtin_amdgcn_mfma_f32_32x32x16_bf16(kf[4],qr[2],C0,0,0,0),   P1[2],P1[3],P1[4],P1[5],     pw2[0]=PKW(P1,0), pw2[1]=PKW(P1,2), pw2); \
    VRD(6); SBAR(); GAPA(C1=__builtin_amdgcn_mfma_f32_32x32x16_bf16(kf[5],qr[2],C1,0,0,0),   P1[6],P1[7],P1[8],P1[9],     pw2[2]=PKW(P1,4), pw2[3]=PKW(P1,6), pw2); \
    VRD(3); SBAR(); GAPA(C0=__builtin_amdgcn_mfma_f32_32x32x16_bf16(kf[6],qr[3],C0,0,0,0),   P1[10],P1[11],P1[12],P1[13], pw3[0]=PKW(P1,8), pw3[1]=PKW(P1,10), pw3); \
    VRD(7); SBAR(); GAPA(C1=__builtin_amdgcn_mfma_f32_32x32x16_bf16(kf[7],qr[3],C1,0,0,0),   P1[14],P1[15],0.f,0.f,       pw3[2]=PKW(P1,12),pw3[3]=PKW(P1,14), pw3); \
    l_reg+=sacc; \
    if(GK){DMA_K((t)+3,sl_cur);} if(GV){DMA_V((t)+1,sl_next);} \
    CMASK(C0,C1,t); \
    { float a=MX3(C0[0],C0[1],C1[0]),b=MX3(C0[2],C0[3],C1[1]); a=MX3(a,C1[2],C1[3]); \
      _Pragma("unroll") for(int r=4;r<16;r+=4){a=MX3(a,C0[r],C0[r+1]);b=MX3(b,C0[r+2],C0[r+3]);a=MX3(a,C1[r],C1[r+1]);b=MX3(b,C1[r+2],C1[r+3]);} \
      float rm=__builtin_fmaxf(a,b); { auto rr=__builtin_amdgcn_permlane32_swap(__float_as_uint(rm),__float_as_uint(rm),false,false); rm=__builtin_fmaxf(__uint_as_float(rr[0]),__uint_as_float(rr[1])); } \
      resc=false; \
      if(__builtin_expect(__any(rm>(float)THRL),0)){ const float dl=__builtin_fmaxf(rm,0.f); mhat+=dl; \
        _Pragma("unroll") for(int r=0;r<16;++r){C0[r]-=dl;C1[r]-=dl;} \
        _Pragma("unroll") for(int r=0;r<16;++r)negm[r]=-mhat; asm volatile("":"+v"(negm)); \
        const float f=__builtin_amdgcn_exp2f(-dl); l_reg*=f; if(hi==0)wsf[r32]=f; resc=true; } } \
    SBAR(); \
    GAPB(o[0]=__builtin_amdgcn_mfma_f32_32x32x16_bf16(PAF(0),VFR(0),o[0],0,0,0), C0,0); VRD2(0); \
    GAPB(o[1]=__builtin_amdgcn_mfma_f32_32x32x16_bf16(PAF(0),VFR(4),o[1],0,0,0), C0,2); VRD2(4); \
    GAPB(o[0]=__builtin_amdgcn_mfma_f32_32x32x16_bf16(PAF(1),VFR(1),o[0],0,0,0), C0,4); VRD2(1); \
    GAPB(o[1]=__builtin_amdgcn_mfma_f32_32x32x16_bf16(PAF(1),VFR(5),o[1],0,0,0), C0,6); VRD2(5); \
    GAPB(o[0]=__builtin_amdgcn_mfma_f32_32x32x16_bf16(PAF(2),VFR(2),o[0],0,0,0), C0,8); VRD2(2); \
    GAPB(o[1]=__builtin_amdgcn_mfma_f32_32x32x16_bf16(PAF(2),VFR(6),o[1],0,0,0), C0,10); VRD2(6); \
    GAPB(o[0]=__builtin_amdgcn_mfma_f32_32x32x16_bf16(PAF(3),VFR(3),o[0],0,0,0), C0,12); VRD2(3); \
    GAPB(o[1]=__builtin_amdgcn_mfma_f32_32x32x16_bf16(PAF(3),VFR(7),o[1],0,0,0), C0,14); VRD2(7); \
    GAPB(o[2]=__builtin_amdgcn_mfma_f32_32x32x16_bf16(PAF(0),VFR(0),o[2],0,0,0), C1,0); \
    KRD(GL,0); GAPB(o[3]=__builtin_amdgcn_mfma_f32_32x32x16_bf16(PAF(0),VFR(4),o[3],0,0,0), C1,2); \
    KRD(GL,1); GAPB(o[2]=__builtin_amdgcn_mfma_f32_32x32x16_bf16(PAF(1),VFR(1),o[2],0,0,0), C1,4); \
    KRD(GL,2); GAPB(o[3]=__builtin_amdgcn_mfma_f32_32x32x16_bf16(PAF(1),VFR(5),o[3],0,0,0), C1,6); \
    KRD(GL,3); GAPB(o[2]=__builtin_amdgcn_mfma_f32_32x32x16_bf16(PAF(2),VFR(2),o[2],0,0,0), C1,8); \
    GAPB(o[3]=__builtin_amdgcn_mfma_f32_32x32x16_bf16(PAF(2),VFR(6),o[3],0,0,0), C1,10); \
    GAPB(o[2]=__builtin_amdgcn_mfma_f32_32x32x16_bf16(PAF(3),VFR(3),o[2],0,0,0), C1,12); \
    GAPB(o[3]=__builtin_amdgcn_mfma_f32_32x32x16_bf16(PAF(3),VFR(7),o[3],0,0,0), C1,14); \
    }while(0)
  int t=1;
  #undef CMASK
  #define CMASK(P0,P1,t) do{}while(0)
  for(;t+5<NT;t+=2){
    STEP(pB0,pB1,pA0,pA1,t,true,true,true);     WAIT_BAR(3); RESC(); ROT();
    STEP(pA0,pA1,pB0,pB1,t+1,true,true,true);   WAIT_BAR(3); RESC(); ROT();
  }
  #undef CMASK
  #define CMASK(P0,P1,t) do{int jb_=(t)-(NT-4); if(jb_>=0)cmask(P0,P1,jb_,qrel,hi);}while(0)
  #define ENDW(tt) do{ if((tt)+3<NT){WAIT_BAR(3);} else if((tt)+2<NT){WAIT_BAR(2);} else {WAIT_BAR(0);} }while(0)
  for(;t+1<NT;t+=2){
    STEP(pB0,pB1,pA0,pA1,t,(t+3<NT),(t+1<NT),(t+1<NT));       ENDW(t);   RESC(); ROT();
    STEP(pA0,pA1,pB0,pB1,t+1,(t+4<NT),(t+2<NT),(t+2<NT));     ENDW(t+1); RESC(); ROT();
  }
  STEP(pB0,pB1,pA0,pA1,NT-1,false,false,false); RESC();
  { float sacc=pB0[0]+pB0[1]; _Pragma("unroll") for(int r=2;r<16;++r)sacc+=pB0[r]; _Pragma("unroll") for(int r=0;r<16;++r)sacc+=pB1[r]; l_reg+=sacc;
    pw0=(u32x4){PKW(pB0,0),PKW(pB0,2),PKW(pB0,4),PKW(pB0,6)};pw1=(u32x4){PKW(pB0,8),PKW(pB0,10),PKW(pB0,12),PKW(pB0,14)};pw2=(u32x4){PKW(pB1,0),PKW(pB1,2),PKW(pB1,4),PKW(pB1,6)};pw3=(u32x4){PKW(pB1,8),PKW(pB1,10),PKW(pB1,12),PKW(pB1,14)};
    SBAR(); pv(o,(int)(unsigned)(unsigned long)(vp0)+2*sl_cur,PAF(0),PAF(1),PAF(2),PAF(3)); }
  #undef PKW
  #undef PAF
  #undef VFR
  #undef PIN
  #undef MX3
  #undef GAPA
  #undef GAPB
  #undef EX
  #undef VRD
  #undef VRD2
  #undef KRD
  #undef STEP
  #undef ENDW
  {auto rr=__builtin_amdgcn_permlane32_swap(__float_as_uint(l_reg),__float_as_uint(l_reg),false,false);l_reg=__uint_as_float(rr[0])+__uint_as_float(rr[1]);}
  if(hi==0)wsf[32+r32]=l_reg;asm volatile("s_waitcnt lgkmcnt(0)":::"memory");
  float rli[16];
  #pragma unroll
  for(int r=0;r<16;++r)rli[r]=__builtin_amdgcn_rcpf(wsf[32+crow(r,hi)]);
  bf16*Ow=O+(rowbase+q0+wid*QBLK)*OPITCH+ocol;
  __attribute__((address_space(3))) unsigned short*stg=(__attribute__((address_space(3))) unsigned short*)(shm+LDS_OST)+wid*2048;
  if(!(h&1)){
    #pragma unroll
    for(int ps=0;ps<2;++ps){
      #pragma unroll
      for(int r=0;r<16;++r){const int orow=crow(r,hi);
        #pragma unroll
        for(int d0=0;d0<2;++d0)stg[orow*64+d0*32+r32]=__builtin_bit_cast(unsigned short,(__bf16)(o[2*ps+d0][r]*rli[r]));}
      asm volatile("s_waitcnt lgkmcnt(0)":::"memory");
      #pragma unroll
      for(int i=0;i<4;++i){const int row=i*8+(lane>>3),ch=lane&7; const u32x4 v=*(const __attribute__((address_space(3))) u32x4*)(stg+row*64+ch*8); ATTN_STORE16(Ow+(long)row*OPITCH+ps*64+ch*8,v);}
      asm volatile("s_waitcnt lgkmcnt(0)":::"memory"); }
  } else {
    float x[2][4][8]; float ss[4]={0.f,0.f,0.f,0.f};
    #pragma unroll
    for(int ps=0;ps<2;++ps){
      u32x4 v0[4];
      #pragma unroll
      for(int i=0;i<4;++i){const int row=i*8+(lane>>3),ch=lane&7; v0[i]=*(const __attribute__((address_space(1))) u32x4*)(Ow-128+(long)row*OPITCH+ps*64+ch*8);}
      #pragma unroll
      for(int r=0;r<16;++r){const int orow=crow(r,hi);
        #pragma unroll
        for(int d0=0;d0<2;++d0)stg[orow*64+d0*32+r32]=__builtin_bit_cast(unsigned short,(__bf16)(o[2*ps+d0][r]*rli[r]));}
      asm volatile("s_waitcnt lgkmcnt(0)":::"memory");
      #pragma unroll
      for(int i=0;i<4;++i){const int row=i*8+(lane>>3),ch=lane&7; const u32x4 v1=*(const __attribute__((address_space(3))) u32x4*)(stg+row*64+ch*8);
        #pragma unroll
        for(int k=0;k<4;++k){ const float a0=__uint_as_float(v0[i][k]<<16),a1=__uint_as_float(v0[i][k]&0xffff0000u),b0=__uint_as_float(v1[k]<<16),b1=__uint_as_float(v1[k]&0xffff0000u);
          const float y0=a0-lam*b0,y1=a1-lam*b1; x[ps][i][2*k]=y0; x[ps][i][2*k+1]=y1; ss[i]+=y0*y0+y1*y1; } }
      asm volatile("s_waitcnt lgkmcnt(0)":::"memory"); }
    bf16*ODw=OD+(rowbase+q0+wid*QBLK)*DM+(h>>1)*128;
    #pragma unroll
    for(int i=0;i<4;++i){ float s_=ss[i]; s_+=shflx(s_,1,lane); s_+=shflx(s_,2,lane); s_+=shflx(s_,4,lane); ss[i]=__builtin_amdgcn_rsqf(s_*(1.0f/128.0f)+1e-5f)*(1.0f-lam_init); }
    #pragma unroll
    for(int ps=0;ps<2;++ps){ const int ch=lane&7; const __attribute__((address_space(1))) u32x4*gp=(const __attribute__((address_space(1))) u32x4*)(subg+ps*64+ch*8); const u32x4 g0=gp[0],g1=gp[1];
      #pragma unroll
      for(int i=0;i<4;++i){const int row=i*8+(lane>>3); const float rs=ss[i]; u32x4 w;
        w[0]=cvtpk_s(x[ps][i][0]*rs*__uint_as_float(g0[0]),x[ps][i][1]*rs*__uint_as_float(g0[1])); w[1]=cvtpk_s(x[ps][i][2]*rs*__uint_as_float(g0[2]),x[ps][i][3]*rs*__uint_as_float(g0[3]));
        w[2]=cvtpk_s(x[ps][i][4]*rs*__uint_as_float(g1[0]),x[ps][i][5]*rs*__uint_as_float(g1[1])); w[3]=cvtpk_s(x[ps][i][6]*rs*__uint_as_float(g1[2]),x[ps][i][7]*rs*__uint_as_float(g1[3]));
        ATTN_STORE16(ODw+(long)row*DM+ps*64+ch*8,w);} }
  }
  asm volatile("s_waitcnt lgkmcnt(0)\n\ts_barrier":::"memory");
  #undef DMA_K
  #undef DMA_V
  #undef CMASK
  #undef START
  #undef RESC
  #undef ROT
}
constexpr int ATTN_LDS_BYTES=LDS_BYTES;
struct AttnTensors { const bf16* Q; const bf16* K; const bf16* V; bf16* O; int wv; bf16* OD; const float* lam4; const float* subg; float lam_init; };
struct AttnUnit { int b; int hq; int qb; };
struct DiffOrder {
  int vcu;
  __device__ __forceinline__ explicit DiffOrder(int v):vcu(v){}
  __device__ __forceinline__ bool next(int i,AttnUnit&u)const{ if(i>=8)return false; const int s=vcu&7,ii=i>>1; const int x=vcu>>3;
    u.b=x>>3; u.hq=2*(x&7)+(i&1); u.qb=(ii==0)?s:(ii==1)?15-s:(ii==2)?16+s:31-s; return true; }
};
template<class Sched,class Hook,int THRL=8> __device__ __forceinline__ void attn_phase(char*lds,const AttnTensors&T,const Sched&S,const Hook&H){
  AttnUnit u;
  const int ln_=tid_opaque(T.wv)&63; const __attribute__((address_space(1))) float*l4_=(const __attribute__((address_space(1))) float*)T.lam4; const float la_=wave_sum(l4_[ln_]*l4_[64+ln_]), lb_=wave_sum(l4_[128+ln_]*l4_[192+ln_]);
  const float lam=__uint_as_float(__builtin_amdgcn_readfirstlane(__float_as_uint(__expf(la_)-__expf(lb_)+T.lam_init)));
  for(int i=0;S.next(i,u);++i){ attn_unit<THRL>(T.wv,u.b,u.hq,(u.hq&~1),u.hq*128,u.qb,T.Q,T.K,T.V,T.O,lds,T.OD,lam,T.subg,T.lam_init); H(i,i==7); }
}
#undef SBAR
#undef WAIT_BAR
}

#ifndef MOE_FP8
#define MOE_FP8 1
#endif
constexpr int NWAVES = 8;
constexpr int T = 32768, D = 1024, SEQ = 8192, NBATCH = 4, DEPTH = 4;
constexpr int NE = 32, TOPK = 4, CAP = 32768, NROWS = T * TOPK + NE * 256;
constexpr int RH = 8, RDK = 128, RDV = 256, RC_ = 128, RNCH = SEQ / RC_;
constexpr float LN_EPS = 1e-5f;
constexpr float DN_ALPHA = 1.6817928305074292f;

constexpr size_t MiB = 1u << 20;
constexpr size_t WS_CTL = 0, CTL_ZERO_BYTES = 1 * MiB;
constexpr size_t WS_WRT = 1 * MiB;
constexpr size_t WS_ROPE_R = 2 * MiB;
constexpr size_t WS_ROPE_D = 6 * MiB;
constexpr size_t WS_TOKE = 7 * MiB, WS_TOKR = WS_TOKE + 512 * 1024, WS_TOKG = 8 * MiB;
constexpr size_t WS_ROWTOK = 12 * MiB;
constexpr size_t WS_WIN = 16 * MiB;
constexpr size_t WS_WROUT = 40 * MiB;
constexpr size_t WS_WKV = 48 * MiB;
constexpr size_t WS_WQ = 52 * MiB;
constexpr size_t WS_WDOUT = 56 * MiB;
#ifndef RET_F8
#define RET_F8 1
#endif
constexpr float RET_KS = 4.0f;
#ifndef CONV_IN_ATTN
#define CONV_IN_ATTN 1
#endif
constexpr size_t WS_WUP = 64 * MiB;
constexpr size_t WS_WDN = 576 * MiB;
constexpr size_t WS_HF = 832 * MiB;
constexpr size_t WS_HB = 960 * MiB;
constexpr size_t WS_SBUF = 1024 * MiB;
constexpr size_t WS_KSH = 1152 * MiB, WS_VSH = 1216 * MiB;
constexpr size_t WS_HQ = 1280 * MiB;
constexpr size_t WS_X = 1312 * MiB;
constexpr size_t WS_PROJ = WS_X, WS_KVT = WS_X + 384 * MiB, WS_STATE = WS_X + 640 * MiB, WS_OG = WS_X + 768 * MiB;
constexpr size_t WS_QD = WS_X, WS_OATT = WS_X + 64 * MiB, WS_OD = WS_X + 192 * MiB;
constexpr size_t WS_HDN = WS_X, WS_Y = WS_X + 272 * MiB;
constexpr size_t WS_END = WS_X + 896 * MiB;
static_assert((size_t)NROWS * 1024 * 2 <= 272 * MiB && (size_t)T * 6144 * 2 <= 384 * MiB, "ws map");
constexpr int CW_BAR = 4096;
constexpr int CW_CNT = 1024;

constexpr int RING_BYTES = 131072;
constexpr int LDSCTL_OFF = RING_BYTES;
constexpr int TAB_TILE_E = LDSCTL_OFF + 512;
constexpr int TAB_TSTART = TAB_TILE_E + 2304;
constexpr int TAB_ROWTAB = TAB_TSTART + 512;
constexpr int LDS_BYTES = TAB_ROWTAB + 18 * 1024;
static_assert(LDS_BYTES <= 163840 && LDS_BYTES % 16 == 0 && WAVE_TAB_LDS_OFF == LDSCTL_OFF + 256, "LDS map");

#define GAS __attribute__((address_space(1)))
#define LAS __attribute__((address_space(3)))
typedef unsigned short bf16;
typedef unsigned v4u __attribute__((ext_vector_type(4)));
typedef unsigned v2u __attribute__((ext_vector_type(2)));
typedef int v4i __attribute__((ext_vector_type(4)));
typedef float f32x4 __attribute__((ext_vector_type(4)));
typedef float f32x16 __attribute__((ext_vector_type(16)));
typedef short bf16x8 __attribute__((ext_vector_type(8)));
typedef short s16x4 __attribute__((ext_vector_type(4)));
typedef GAS unsigned gu32;
#define RLX_AGENT __ATOMIC_RELAXED, __HIP_MEMORY_SCOPE_AGENT
__device__ __forceinline__ unsigned f2bf(float f) { unsigned u = __builtin_bit_cast(unsigned, f); return (u + 0x7fffu + ((u >> 16) & 1u)) >> 16; }
__device__ __forceinline__ unsigned pk2(float lo, float hi) { return pg8::cvt_pk_bf16(lo, hi); }
__device__ __forceinline__ float bf2f(unsigned short b) { return __builtin_bit_cast(float, (unsigned)b << 16); }
__device__ __forceinline__ float bflo(unsigned w) { return __builtin_bit_cast(float, w << 16); }
__device__ __forceinline__ float bfhi(unsigned w) { return __builtin_bit_cast(float, w & 0xffff0000u); }

#define XB_TMO      128
#define XB_XCNT(j)  (256  + 64 * (j))
#define XB_XSUB(j)  (1280 + 64 * (j))
#define XB_XGEN(j)  (2304 + 64 * (j))
#define XB_TOP      3328
#define XB_TOPGEN   3392
#define XCD_BAR_WORDS 3456
#define XB_SPIN_CAP (1u << 22)

__device__ __forceinline__ unsigned xb_ld(unsigned* p)              { return __hip_atomic_load(p, __ATOMIC_RELAXED, __HIP_MEMORY_SCOPE_AGENT); }
__device__ __forceinline__ unsigned xb_add(unsigned* p, unsigned v) { return __hip_atomic_fetch_add(p, v, __ATOMIC_RELAXED, __HIP_MEMORY_SCOPE_AGENT); }
__device__ __forceinline__ unsigned xb_xcc_id() { return (unsigned)__builtin_amdgcn_s_getreg((3 << 11) | 20) & 0xFu; }
#define XB_SPIN(cond, bar) do { unsigned _sp = 0; while (cond) { __builtin_amdgcn_s_sleep(1); \
    if ((++_sp & 255u) == 0u) { if (xb_ld(&(bar)[XB_TMO])) break; if (_sp > XB_SPIN_CAP) { atomicAdd(&(bar)[XB_TMO], 1u); break; } } } } while (0)

struct XcdBarrier {
    unsigned* bar; unsigned x;
    volatile LAS unsigned* st; int wv;
};
__device__ __forceinline__ bool xb_thread0(int) { return tid_opaque(wave_index()) == 0; }
__device__ __forceinline__ XcdBarrier xcd_barrier_post(unsigned* bar, volatile LAS unsigned* st, int wv) {
    XcdBarrier b; b.bar = bar; b.x = xb_xcc_id(); b.st = st; b.wv = wv;
    if (xb_thread0(wv)) (void)xb_add(&bar[XB_XCNT(b.x)], 1u);
    return b;
}
__device__ __forceinline__ void xcd_barrier_complete(unsigned* bar, unsigned x, unsigned& nloc, unsigned& nx) {
    const unsigned G = gridDim.x * gridDim.y * gridDim.z;
    unsigned sum, cnt, mine, sp = 0u;
    for (;;) {
        sum = 0u; cnt = 0u; mine = 0u;
#pragma unroll
        for (unsigned j = 0; j < 16; ++j) { const unsigned c = xb_ld(&bar[XB_XCNT(j)]); sum += c; cnt += (c > 0u) ? 1u : 0u; mine = (j == x) ? c : mine; }
        if (sum == G) break;
        __builtin_amdgcn_s_sleep(1);
        if ((++sp & 255u) == 0u) { if (xb_ld(&bar[XB_TMO])) break; if (sp > XB_SPIN_CAP) { atomicAdd(&bar[XB_TMO], 1u); break; } }
    }
    nloc = mine > 0u ? mine : 1u; nx = cnt > 0u ? cnt : 1u;
}
__device__ __forceinline__ void xcd_barrier(const XcdBarrier& b) {
    asm volatile("s_waitcnt vmcnt(0)" ::: "memory");
    __syncthreads();
    if (xb_thread0(b.wv)) {
        unsigned* bar = b.bar;
        __builtin_amdgcn_s_waitcnt(0);
        unsigned nloc = b.st[0], nx = b.st[1];
        if (nloc == 0u) { xcd_barrier_complete(bar, b.x, nloc, nx); b.st[0] = nloc; b.st[1] = nx; }
        const unsigned old = xb_add(&bar[XB_XSUB(b.x)], 1u);
        const unsigned gen = old / nloc;
        if (old + 1u == (gen + 1u) * nloc) {
            __builtin_amdgcn_fence(__ATOMIC_RELEASE, "agent");
            asm volatile("s_waitcnt vmcnt(0)" ::: "memory");
            const unsigned og = xb_add(&bar[XB_TOP], 1u);
            const unsigned tg = og / nx;
            if (og + 1u == (tg + 1u) * nx) xb_add(&bar[XB_TOPGEN], 1u);
            else XB_SPIN(xb_ld(&bar[XB_TOPGEN]) == tg, bar);
            __builtin_amdgcn_fence(__ATOMIC_ACQUIRE, "agent");
            xb_add(&bar[XB_XGEN(b.x)], 1u);
            asm volatile("s_waitcnt vmcnt(0)" ::: "memory");
        } else {
            XB_SPIN(xb_ld(&bar[XB_XGEN(b.x)]) == gen, bar);
            __builtin_amdgcn_fence(__ATOMIC_ACQUIRE, "agent");
            asm volatile("s_waitcnt vmcnt(0)" ::: "memory");
        }
    }
    __syncthreads();
}
template <int MODE> __device__ __forceinline__ int dst_row(int n) {
    if (MODE == 1) { if (n < 2048) { const int d = n & 127; const int p = d < 64 ? (8 * (d >> 2) + (d & 3)) : (8 * ((d - 64) >> 2) + 4 + (d & 3)); return (n & ~127) + p; } return n; }
    if (MODE == 2) { if (n < 1024) { const int d = n & 63; if (d < 16) { const int p = d < 8 ? (8 * (d >> 2) + (d & 3)) : (8 * ((d - 8) >> 2) + 4 + (d & 3)); return (n & ~63) + p; } } return n; }
    if (MODE == 3) { return n < 1024 ? (256 * (n >> 7) + (n & 127)) : (256 * ((n - 1024) >> 7) + 128 + ((n - 1024) & 127)); }
    return n;
}
template <int MODE, bool FP8> __device__ __forceinline__ void transpose_item(const float* W_, int K, int N, unsigned char* WT, LAS unsigned* scr, int item, int lane) {
    const GAS float* W = (const GAS float*)W_;
    constexpr int R = FP8 ? 4 : 2, KI = 32 * R, EB = FP8 ? 1 : 2;
    const int nblk = N / 64, kb = item / nblk, nb = item - kb * nblk, k0 = KI * kb, n0 = 64 * nb;
    const int ks = lane >> 4, n4 = 4 * (lane & 15);
    f32x4 v[8][R];
#pragma unroll
    for (int i = 0; i < 8; ++i)
#pragma unroll
        for (int r = 0; r < R; ++r) v[i][r] = __builtin_nontemporal_load((const GAS f32x4*)(W + (size_t)(k0 + 4 * R * i + R * ks + r) * N + n0 + n4));
#pragma unroll
    for (int i = 0; i < 8; ++i) { LAS unsigned* row = scr + (4 * i + ks) * 65 + n4;
#pragma unroll
        for (int j = 0; j < 4; ++j) {
            unsigned w;
            if constexpr (FP8) { int t = __builtin_amdgcn_cvt_pk_fp8_f32(v[i][0][j] * 64.0f, v[i][1][j] * 64.0f, 0, false); t = __builtin_amdgcn_cvt_pk_fp8_f32(v[i][2][j] * 64.0f, v[i][3][j] * 64.0f, t, true); w = (unsigned)t; }
            else w = pk2(v[i][0][j], v[i][1][j]);
            row[j] = w; } }
    asm volatile("s_waitcnt lgkmcnt(0)" ::: "memory");
    const int c = lane & 7, nl = lane >> 3;
#pragma unroll
    for (int j = 0; j < 8; ++j) { const int n = nl + 8 * j; const LAS unsigned* s = scr + (4 * c) * 65 + n;
        v4u o; o.x = s[0]; o.y = s[65]; o.z = s[130]; o.w = s[195];
        __builtin_nontemporal_store(o, (GAS v4u*)(WT + ((size_t)dst_row<MODE>(n0 + n) * K + k0 + 4 * R * c) * EB)); }
    asm volatile("s_waitcnt lgkmcnt(0)" ::: "memory");
}
template <int MODE, bool FP8> __device__ __forceinline__ void transpose_all(const float* W, int K, int N, int nmat, void* WT, LAS unsigned* scr, int gw, int NGW, int lane) {
    constexpr int KI = FP8 ? 128 : 64, EB = FP8 ? 1 : 2;
    const int per = (K / KI) * (N / 64); const int total = per * nmat;
    for (int it = gw; it < total; it += NGW) { const int mat = it / per, item = it - mat * per; transpose_item<MODE, FP8>(W + (size_t)mat * K * N, K, N, (unsigned char*)WT + (size_t)mat * K * N * EB, scr, item, lane); }
}
__device__ __forceinline__ double exp2_d(double x) {
    const double n = __builtin_rint(x), z = (x - n) * 0.69314718055994530942;
    double p = 1.0 / 6227020800.0; p = p * z + 1.0 / 479001600.0; p = p * z + 1.0 / 39916800.0; p = p * z + 1.0 / 3628800.0; p = p * z + 1.0 / 362880.0; p = p * z + 1.0 / 40320.0; p = p * z + 1.0 / 5040.0;
    p = p * z + 1.0 / 720.0; p = p * z + 1.0 / 120.0; p = p * z + 1.0 / 24.0; p = p * z + 1.0 / 6.0; p = p * z + 0.5; p = p * z + 1.0; p = p * z + 1.0;
    return p * __builtin_bit_cast(double, (unsigned long long)(1023 + (long long)n) << 52);
}
__device__ __forceinline__ void sincos_d(double a, float& s, float& c) {
    const double k = __builtin_rint(a * 0.63661977236758134308), y = __builtin_fma(-k, 1.57079632679489661923, a) - k * 6.123233995736766e-17;
    const double y2 = y * y;
    double sp = -2.5052108385441718775e-8; sp = sp * y2 + 2.7557319223985890653e-6; sp = sp * y2 - 1.9841269841269841270e-4; sp = sp * y2 + 8.3333333333333333333e-3; sp = sp * y2 - 1.6666666666666666667e-1; sp = y + y * y2 * sp;
    double cp = 2.0876756987868098979e-9; cp = cp * y2 - 2.7557319223985890653e-7; cp = cp * y2 + 2.4801587301587301587e-5; cp = cp * y2 - 1.3888888888888888889e-3; cp = cp * y2 + 4.1666666666666666667e-2; cp = cp * y2 - 0.5; cp = 1.0 + y2 * cp;
    const int q = (int)((long long)k & 3);
    const double ss = (q == 0) ? sp : (q == 1) ? cp : (q == 2) ? -sp : -cp;
    const double cc = (q == 0) ? cp : (q == 1) ? -sp : (q == 2) ? -cp : sp;
    s = (float)ss; c = (float)cc;
}

struct Ptrs {
    const float *x, *ret_w_in, *ret_w_out, *kv_w, *diff_w_q, *diff_lambda, *diff_subln_g, *diff_w_out, *ln_attn_g, *ln_attn_b, *ln_ffn_g, *ln_ffn_b,
                *moe_w_router, *moe_b_router, *moe_w_up, *moe_b_up, *moe_w_down, *moe_b_down;
    float* out; unsigned char* ws;
    int ph_lo, ph_hi, li, pad;
};

enum PtrIdx { PI_X = 0, PI_RET_W_IN, PI_RET_W_OUT, PI_KV_W, PI_DIFF_W_Q, PI_DIFF_LAMBDA, PI_DIFF_SUBLN_G, PI_DIFF_W_OUT, PI_LN_ATTN_G, PI_LN_ATTN_B, PI_LN_FFN_G, PI_LN_FFN_B,
              PI_W_ROUTER, PI_B_ROUTER, PI_W_UP, PI_B_UP, PI_W_DOWN, PI_B_DOWN, PI_OUT, PI_WS, PI_N };
__device__ __forceinline__ unsigned long long ldp_raw(const LAS unsigned long long*, int i) {
    const __attribute__((address_space(4))) unsigned long long* kp = (const __attribute__((address_space(4))) unsigned long long*)__builtin_amdgcn_kernarg_segment_ptr();
    asm volatile("" : "+s"(kp));
    return kp[i];
}
#define LDPF(i) ((const float*)ldp_raw(PT, (i)))
constexpr int CONV_UP_ITEMS = 32 * (1024 / 128) * (2048 / 64), CONV_DN_ITEMS = 32 * (1024 / 128) * (1024 / 64);
struct ConvHook {
    const LAS unsigned long long* PT; LAS unsigned char* L; int l, gw, NGW, wv;
    __device__ __forceinline__ void one(int it, LAS unsigned* scr, int lane) const {
        unsigned char* ws = (unsigned char*)ldp_raw(PT, PI_WS);
        if (it < CONV_UP_ITEMS) { const int mat = it >> 8, item = it & 255;
            transpose_item<3, true>(LDPF(PI_W_UP) + ((size_t)l * 32 + mat) * 1024 * 2048, 1024, 2048, ws + WS_WUP + ((size_t)l * 32 + mat) * 2048 * 1024, scr, item, lane); }
        else if (it < CONV_UP_ITEMS + CONV_DN_ITEMS) { const int i2 = it - CONV_UP_ITEMS; const int mat = i2 >> 7, item = i2 & 127;
            transpose_item<0, true>(LDPF(PI_W_DOWN) + ((size_t)l * 32 + mat) * 1024 * 1024, 1024, 1024, ws + WS_WDN + ((size_t)l * 32 + mat) * 1024 * 1024, scr, item, lane); }
    }
    __device__ __forceinline__ void operator()(int i, bool lastu) const {
        const int lane = tid_opaque(wv) & 63; LAS unsigned* scr = (LAS unsigned*)(L + wv * 8448);
        if (!lastu) { if (gw - wv + NGW * i < CONV_UP_ITEMS + CONV_DN_ITEMS) { one(gw + NGW * i, scr, lane); asm volatile("s_waitcnt lgkmcnt(0)\n\ts_barrier" ::: "memory"); } }
        else for (int it = gw + NGW * i; it < CONV_UP_ITEMS + CONV_DN_ITEMS; it += NGW) one(it, scr, lane);
    }
};
struct NoHook { __device__ __forceinline__ void operator()(int, bool) const {} };
__device__ __forceinline__ void phase_prologue(LAS unsigned char* lds, const LAS unsigned long long* PT, int vcu, int G, int wv) {
    const int tid = tid_opaque(wv), lane = tid & 63, wave = wv;
    LAS unsigned* scr = (LAS unsigned*)(lds + wave * 8448);
    const int gw = vcu * NWAVES + wave, NGW = G * NWAVES;
    unsigned char* ws = (unsigned char*)ldp_raw(PT, PI_WS);
    transpose_all<3, MOE_FP8>(LDPF(PI_W_UP), 1024, 2048, CONV_IN_ATTN ? 64 : 128, (void*)(ws + WS_WUP), scr, gw, NGW, lane);
    transpose_all<0, MOE_FP8>(LDPF(PI_W_DOWN), 1024, 1024, CONV_IN_ATTN ? 64 : 128, (void*)(ws + WS_WDN), scr, gw, NGW, lane);
    transpose_all<1, false>(LDPF(PI_RET_W_IN), 1024, 6144, 2, (void*)(ws + WS_WIN), scr, gw, NGW, lane);
    transpose_all<0, false>(LDPF(PI_RET_W_OUT), 2048, 1024, 2, (void*)(ws + WS_WROUT), scr, gw, NGW, lane);
    transpose_all<2, false>(LDPF(PI_KV_W), 1024, 2048, 1, (void*)(ws + WS_WKV), scr, gw, NGW, lane);
    transpose_all<2, false>(LDPF(PI_DIFF_W_Q), 1024, 1024, 2, (void*)(ws + WS_WQ), scr, gw, NGW, lane);
    transpose_all<0, false>(LDPF(PI_DIFF_W_OUT), 1024, 1024, 2, (void*)(ws + WS_WDOUT), scr, gw, NGW, lane);
    const int gt = vcu * (NWAVES * 64) + tid, NGT = G * NWAVES * 64;
    { GAS float* cr = (GAS float*)(ws + WS_ROPE_R); GAS float* sr = cr + SEQ * 64;
      for (int i = gt; i < SEQ * 64; i += NGT) { const int pos = i >> 6, f = i & 63;
          const float lin = (float)f / 63.0f; const float inv = (float)exp2_d(-(double)lin * 13.287712379549449);
          const float ang = (float)pos * inv; float s, c; sincos_d((double)ang, s, c); cr[i] = c; sr[i] = s; }
      GAS float* cd = (GAS float*)(ws + WS_ROPE_D); GAS float* sd = cd + SEQ * 8;
      for (int i = gt; i < SEQ * 8; i += NGT) { const int pos = i >> 3, f = i & 7;
          const float ex = (float)(2 * f) / 16.0f; const float inv = (float)exp2_d(-(double)ex * 18.931568569324174);
          const float ang = (float)pos * inv; float s, c; sincos_d((double)ang, s, c); cd[i] = c; sd[i] = s; } }
    { GAS bf16* wrt = (GAS bf16*)(ws + WS_WRT); const GAS float* wrouter = (const GAS float*)LDPF(PI_W_ROUTER);
      for (int i = gt; i < DEPTH * 32 * 1024; i += NGT) { const int l = i >> 15, e = (i >> 10) & 31, k = i & 1023;
          const float w = wrouter[((size_t)l * 1024 + k) * 32 + e]; const unsigned hi = f2bf(w); const float r = w - bf2f((unsigned short)hi);
          wrt[((size_t)(l * 2 + 0) * 32 + e) * 1024 + k] = (bf16)hi; wrt[((size_t)(l * 2 + 1) * 32 + e) * 1024 + k] = (bf16)f2bf(r); } }
    { GAS bf16* hb = (GAS bf16*)(ws + WS_HB); const GAS float* xin = (const GAS float*)LDPF(PI_X);
      for (int i0 = gt; i0 < T * D / 8; i0 += 8 * NGT) {
          f32x4 a[8], b[8];
#pragma unroll
          for (int u = 0; u < 8; ++u) { const int i = i0 + u * NGT; if (i < T * D / 8) { a[u] = __builtin_nontemporal_load((const GAS f32x4*)(xin + (size_t)i * 8)); b[u] = __builtin_nontemporal_load((const GAS f32x4*)(xin + (size_t)i * 8 + 4)); } }
#pragma unroll
          for (int u = 0; u < 8; ++u) { const int i = i0 + u * NGT; if (i < T * D / 8) { v4u o; o.x = pk2(a[u][0], a[u][1]); o.y = pk2(a[u][2], a[u][3]); o.z = pk2(b[u][0], b[u][1]); o.w = pk2(b[u][2], b[u][3]); *(GAS v4u*)(hb + (size_t)i * 8) = o; } } } }
}

__device__ __forceinline__ void block_rowstats(const float (&x)[4][8], LAS float* red, LAS float* red2, int w, int lane, float& mean, float& rstd) {
    const int row = lane & 15;
    float s = 0.f;
#pragma unroll
    for (int i = 0; i < 4; ++i)
#pragma unroll
        for (int j = 0; j < 8; ++j) s += x[i][j];
    s += shflx(s, 16, lane); s += shflx(s, 32, lane);
    if (lane < 16) red[w * 16 + row] = s;
    __syncthreads();
    float tot = 0.f;
#pragma unroll
    for (int k = 0; k < 8; ++k) tot += red[k * 16 + row];
    mean = tot * (1.0f / 1024.0f);
    float q = 0.f;
#pragma unroll
    for (int i = 0; i < 4; ++i)
#pragma unroll
        for (int j = 0; j < 8; ++j) { const float d = x[i][j] - mean; q += d * d; }
    q += shflx(q, 16, lane); q += shflx(q, 32, lane);
    if (lane < 16) red2[w * 16 + row] = q;
    __syncthreads();
    float tq = 0.f;
#pragma unroll
    for (int k = 0; k < 8; ++k) tq += red2[k * 16 + row];
    rstd = 1.0f / sqrtf(tq * (1.0f / 1024.0f) + LN_EPS);
}

__device__ __forceinline__ void phase_R(LAS unsigned char* lds, const bf16* sbuf_, const float* gam_, const float* bet_, bf16* hb_, unsigned char* hq_, const bf16* wrt_, const float* brouter_,
                                        unsigned* gcnt_, int* row_tok_, int* tok_e_, int* tok_r_, float* tok_g_, float* stat_, int vcu, int G, int wv) {
    GAS float* stat = (GAS float*)stat_;
    const GAS bf16* sbuf = (const GAS bf16*)sbuf_; const GAS float* gam = (const GAS float*)gam_; const GAS float* bet = (const GAS float*)bet_; GAS bf16* hb = (GAS bf16*)hb_; GAS unsigned char* hq = (GAS unsigned char*)hq_;
    const GAS bf16* wrt = (const GAS bf16*)wrt_; const GAS float* brouter = (const GAS float*)brouter_; GAS unsigned* gcnt = (GAS unsigned*)gcnt_; GAS int* row_tok = (GAS int*)row_tok_; GAS int* tok_e = (GAS int*)tok_e_; GAS int* tok_r = (GAS int*)tok_r_; GAS float* tok_g = (GAS float*)tok_g_;
    const int tid = tid_opaque(wv), lane = tid & 63, w = wv, row = lane & 15, kg = lane >> 4;
    LAS float* red = (LAS float*)lds; LAS float* red2 = red + 128; LAS float* part = red + 256;
    LAS float* logit = part + 4096;
    LAS int* sel_e = (LAS int*)(logit + 128 * 33); LAS float* sel_g = (LAS float*)(sel_e + 512);
    LAS unsigned* hist = (LAS unsigned*)(sel_g + 512); LAS unsigned* basew = hist + 32;
    bf16x8 wh[4][2], wl[4][2];
#pragma unroll
    for (int s = 0; s < 4; ++s)
#pragma unroll
        for (int nt = 0; nt < 2; ++nt) { const size_t o = (size_t)(16 * nt + row) * 1024 + 128 * w + 32 * s + 8 * kg; wh[s][nt] = *(const GAS bf16x8*)(wrt + o); wl[s][nt] = *(const GAS bf16x8*)(wrt + 32 * 1024 + o); }
    f32x4 gmr[4][2], btr[4][2];
#pragma unroll
    for (int s = 0; s < 4; ++s) { const int c0 = 128 * w + 32 * s + 8 * kg; gmr[s][0] = *(const GAS f32x4*)(gam + c0); gmr[s][1] = *(const GAS f32x4*)(gam + c0 + 4); btr[s][0] = *(const GAS f32x4*)(bet + c0); btr[s][1] = *(const GAS f32x4*)(bet + c0 + 4); }
    for (int tb = vcu; tb < T / 128; tb += G) {
        if (tid < 32) hist[tid] = 0u;
        v4u xa[4];
        { const size_t rb0 = (size_t)(tb * 128 + row) * 1024 + 128 * w + 8 * kg;
#pragma unroll
          for (int s = 0; s < 4; ++s) xa[s] = *(const GAS v4u*)(sbuf + rb0 + 32 * s); }
        for (int it = 0; it < 8; ++it) {
            const int t = tb * 128 + it * 16 + row;
            const size_t rb = (size_t)t * 1024 + 128 * w + 8 * kg;
            float x[4][8];
#pragma unroll
            for (int s = 0; s < 4; ++s) { x[s][0] = bflo(xa[s].x); x[s][1] = bfhi(xa[s].x); x[s][2] = bflo(xa[s].y); x[s][3] = bfhi(xa[s].y); x[s][4] = bflo(xa[s].z); x[s][5] = bfhi(xa[s].z); x[s][6] = bflo(xa[s].w); x[s][7] = bfhi(xa[s].w); }
            if (it < 7) {
#pragma unroll
                for (int s = 0; s < 4; ++s) xa[s] = *(const GAS v4u*)(sbuf + rb + 16 * 1024 + 32 * s); }
            float mean, rstd; block_rowstats(x, red, red2, w, lane, mean, rstd);
            if (MOE_FP8 && w == 0 && lane < 16) { typedef float f32x2s __attribute__((ext_vector_type(2))); *(GAS f32x2s*)(stat + 2 * (size_t)t) = (f32x2s){mean, rstd}; }
            pg8::f32x4 acc0 = {0.f, 0.f, 0.f, 0.f}, acc1 = {0.f, 0.f, 0.f, 0.f};
#pragma unroll
            for (int s = 0; s < 4; ++s) {
                const f32x4 g0 = gmr[s][0], g1 = gmr[s][1], b0 = btr[s][0], b1 = btr[s][1];
                float y[8];
#pragma unroll
                for (int j = 0; j < 4; ++j) { y[j] = (x[s][j] - mean) * rstd * g0[j] + b0[j]; y[4 + j] = (x[s][4 + j] - mean) * rstd * g1[j] + b1[j]; }
                v4u hi; hi.x = pk2(y[0], y[1]); hi.y = pk2(y[2], y[3]); hi.z = pk2(y[4], y[5]); hi.w = pk2(y[6], y[7]);
                if (!MOE_FP8) *(GAS v4u*)(hb + rb + 32 * s) = hi;
                if (MOE_FP8) { int w0 = __builtin_amdgcn_cvt_pk_fp8_f32(y[0] * 4.0f, y[1] * 4.0f, 0, false); w0 = __builtin_amdgcn_cvt_pk_fp8_f32(y[2] * 4.0f, y[3] * 4.0f, w0, true);
                    int w1 = __builtin_amdgcn_cvt_pk_fp8_f32(y[4] * 4.0f, y[5] * 4.0f, 0, false); w1 = __builtin_amdgcn_cvt_pk_fp8_f32(y[6] * 4.0f, y[7] * 4.0f, w1, true);
                    *(GAS v2u*)(hq + rb + 32 * s) = (v2u){(unsigned)w0, (unsigned)w1}; }
                v4u lo; lo.x = pk2(y[0] - bflo(hi.x), y[1] - bfhi(hi.x)); lo.y = pk2(y[2] - bflo(hi.y), y[3] - bfhi(hi.y)); lo.z = pk2(y[4] - bflo(hi.z), y[5] - bfhi(hi.z)); lo.w = pk2(y[6] - bflo(hi.w), y[7] - bfhi(hi.w));
                const bf16x8 ah = __builtin_bit_cast(bf16x8, hi), al = __builtin_bit_cast(bf16x8, lo);
                acc0 = __builtin_amdgcn_mfma_f32_16x16x32_bf16(ah, wh[s][0], acc0, 0, 0, 0); acc0 = __builtin_amdgcn_mfma_f32_16x16x32_bf16(ah, wl[s][0], acc0, 0, 0, 0); acc0 = __builtin_amdgcn_mfma_f32_16x16x32_bf16(al, wh[s][0], acc0, 0, 0, 0);
                acc1 = __builtin_amdgcn_mfma_f32_16x16x32_bf16(ah, wh[s][1], acc1, 0, 0, 0); acc1 = __builtin_amdgcn_mfma_f32_16x16x32_bf16(ah, wl[s][1], acc1, 0, 0, 0); acc1 = __builtin_amdgcn_mfma_f32_16x16x32_bf16(al, wh[s][1], acc1, 0, 0, 0); }
#pragma unroll
            for (int r = 0; r < 4; ++r) { part[(w * 16 + 4 * kg + r) * 32 + row] = acc0[r]; part[(w * 16 + 4 * kg + r) * 32 + 16 + row] = acc1[r]; }
            __syncthreads();
            { const int tk = tid >> 5, e = tid & 31; float v = brouter[e];
#pragma unroll
              for (int k = 0; k < 8; ++k) v += part[(k * 16 + tk) * 32 + e];
              logit[(it * 16 + tk) * 33 + e] = v; }
        }
        __syncthreads();
        if (tid < 128) {
            float v[32];
#pragma unroll
            for (int e = 0; e < 32; ++e) v[e] = logit[tid * 33 + e];
            float tv[4]; int ti[4];
#pragma unroll
            for (int k = 0; k < 4; ++k) { float bv = -INFINITY; int bi = 0;
#pragma unroll
                for (int e = 0; e < 32; ++e) { const bool gt = v[e] > bv; bv = gt ? v[e] : bv; bi = gt ? e : bi; }
                tv[k] = bv; ti[k] = bi;
#pragma unroll
                for (int e = 0; e < 32; ++e) v[e] = (e == bi) ? -INFINITY : v[e]; }
            const float e1 = __expf(tv[1] - tv[0]), e2 = __expf(tv[2] - tv[0]), e3 = __expf(tv[3] - tv[0]); const float inv = 1.0f / (1.0f + e1 + e2 + e3);
            const int o = tid * 4;
            sel_e[o] = ti[0]; sel_e[o + 1] = ti[1]; sel_e[o + 2] = ti[2]; sel_e[o + 3] = ti[3];
            sel_g[o] = inv; sel_g[o + 1] = e1 * inv; sel_g[o + 2] = e2 * inv; sel_g[o + 3] = e3 * inv;
        }
        __syncthreads();
        const int e = sel_e[tid];
        const unsigned rl = __hip_atomic_fetch_add(hist + e, 1u, __ATOMIC_RELAXED, __HIP_MEMORY_SCOPE_WORKGROUP);
        __syncthreads();
        if (tid < 32) basew[tid] = __hip_atomic_fetch_add(gcnt + tid, hist[tid], __ATOMIC_RELAXED, __HIP_MEMORY_SCOPE_AGENT);
        __syncthreads();
        { const int r = (int)(basew[e] + rl), tok = tb * 128 + (tid >> 2);
          row_tok[(size_t)e * CAP + r] = tok; tok_e[tok * 4 + (tid & 3)] = e; tok_r[tok * 4 + (tid & 3)] = r; tok_g[tok * 4 + (tid & 3)] = sel_g[tid]; }
        __syncthreads();
    }
}

__device__ __forceinline__ void moe_tables(LAS unsigned char* ldsall, const unsigned* gcnt_, int wv) {
    const GAS unsigned* gcnt = (const GAS unsigned*)gcnt_;
    LAS int* tile_e = (LAS int*)(ldsall + TAB_TILE_E); LAS int* tstart = (LAS int*)(ldsall + TAB_TSTART);
    const int tid = tid_opaque(wv);
    if (tid < 64) {
        const int c = tid < 32 ? (int)gcnt[tid] : 0; const int nt = (c + 255) >> 8;
        int incl = nt;
#pragma unroll
        for (int o = 1; o < 32; o <<= 1) { const int v = __builtin_amdgcn_ds_bpermute(((tid - o) & 63) << 2, incl); if ((tid & 63) >= o) incl += v; }
        const int excl = incl - nt;
        if (tid < 32) { tstart[tid] = excl; tstart[64 + tid] = c; for (int k = 0; k < nt; ++k) tile_e[excl + k] = tid; }
        if (tid == 31) tstart[32] = incl;
    }
    __syncthreads();
}

__device__ __forceinline__ void phase_C(LAS unsigned char* ldsall, const bf16* hres_  , const float* stat_, const float* gama_, const float* beta_, const void* ybuf__, const int* tok_e_, const int* tok_r_, const float* tok_g_, const unsigned* gcnt,
                                        const float* gam_, const float* bet_, float* outf_, bf16* hb_, int vcu, int G, int wv) {
    const GAS bf16* hres = (const GAS bf16*)hres_; const GAS unsigned char* ybuf_ = (const GAS unsigned char*)ybuf__; const GAS int* tok_e = (const GAS int*)tok_e_; const GAS int* tok_r = (const GAS int*)tok_r_; const GAS float* tok_g = (const GAS float*)tok_g_;
    const GAS float* gam = (const GAS float*)gam_; const GAS float* bet = (const GAS float*)bet_; GAS float* outf = (GAS float*)outf_; GAS bf16* hb = (GAS bf16*)hb_;
    const int tid = tid_opaque(wv), lane = tid & 63, wave = wv;
    const LAS int* tstart = (const LAS int*)(ldsall + TAB_TSTART);
    moe_tables(ldsall, gcnt, wv);
    typedef float f32x2_ __attribute__((ext_vector_type(2))); constexpr int CROWS = 4;
    f32x4 gm[4], bt[4], ga[4], ba[4];
    const GAS float* stat = (const GAS float*)stat_;
#pragma unroll
    for (int j = 0; j < 4; ++j) { gm[j] = *(const GAS f32x4*)(gam + 4 * lane + 256 * j); bt[j] = *(const GAS f32x4*)(bet + 4 * lane + 256 * j);
        if (MOE_FP8) { ga[j] = *(const GAS f32x4*)((const GAS float*)gama_ + 4 * lane + 256 * j) * DN_ALPHA; ba[j] = *(const GAS f32x4*)((const GAS float*)beta_ + 4 * lane + 256 * j) * DN_ALPHA; } }
    const int gw = vcu * NWAVES + wave, NGW = G * NWAVES;
    for (int rg = gw; rg < T / 16; rg += NGW) {
        const int t0 = rg * 16;
        int myoff[4]; float myg[4]; float mymean = 0.f, myrstd = 0.f;
        if (MOE_FP8) { typedef float f32x2s __attribute__((ext_vector_type(2))); const f32x2s st = *(const GAS f32x2s*)(stat + 2 * (size_t)(t0 + (lane & 15))); mymean = st[0]; myrstd = st[1]; }
        { const int t = t0 + (lane & 15); const v4i e4 = *(const GAS v4i*)(tok_e + t * 4), r4 = *(const GAS v4i*)(tok_r + t * 4); const f32x4 g4 = *(const GAS f32x4*)(tok_g + t * 4);
#pragma unroll
          for (int k = 0; k < 4; ++k) { myoff[k] = tstart[e4[k]] * 256 + r4[k]; myg[k] = g4[k]; } }
        for (int i = 0; i < 16; i += CROWS) {
            v2u a[CROWS][4]; v2u yv[CROWS][4][4]; unsigned y8[CROWS][4][4]; float gk[CROWS][4];
#pragma unroll
            for (int r = 0; r < CROWS; ++r) { const size_t rb = (size_t)(t0 + i + r) * 1024 + 4 * lane;
#pragma unroll
                for (int j = 0; j < 4; ++j) a[r][j] = *(const GAS v2u*)(hres + rb + 256 * j);
#pragma unroll
                for (int k = 0; k < 4; ++k) { const size_t yo = (size_t)__builtin_amdgcn_readlane(myoff[k], i + r) * 1024 + 4 * lane; gk[r][k] = __builtin_bit_cast(float, __builtin_amdgcn_readlane(__builtin_bit_cast(int, myg[k]), i + r)) * (MOE_FP8 ? (1.0f / 32.0f) : 1.0f);
#pragma unroll
                    for (int j = 0; j < 4; ++j) { if (MOE_FP8) y8[r][k][j] = *(const GAS unsigned*)(ybuf_ + yo + 256 * j); else yv[r][k][j] = *(const GAS v2u*)((const GAS bf16*)ybuf_ + yo + 256 * j); } } }
#pragma unroll
            for (int r = 0; r < CROWS; ++r) { const size_t rb = (size_t)(t0 + i + r) * 1024 + 4 * lane;
                f32x4 x[4]; float s = 0.f;
                const float rmean = __builtin_bit_cast(float, __builtin_amdgcn_readlane(__builtin_bit_cast(int, mymean), i + r)), rrstd = __builtin_bit_cast(float, __builtin_amdgcn_readlane(__builtin_bit_cast(int, myrstd), i + r));
#pragma unroll
                for (int j = 0; j < 4; ++j) { const f32x4 v = (f32x4){bflo(a[r][j].x), bfhi(a[r][j].x), bflo(a[r][j].y), bfhi(a[r][j].y)};
                    if (MOE_FP8) x[j] = ((v - rmean) * rrstd) * ga[j] + ba[j]; else x[j] = v * DN_ALPHA;
#pragma unroll
                    for (int k = 0; k < 4; ++k) { const float g = gk[r][k];
                        if (MOE_FP8) { const f32x2_ lo2 = __builtin_amdgcn_cvt_pk_f32_fp8((int)y8[r][k][j], false), hi2 = __builtin_amdgcn_cvt_pk_f32_fp8((int)y8[r][k][j], true); x[j][0] += g * lo2[0]; x[j][1] += g * lo2[1]; x[j][2] += g * hi2[0]; x[j][3] += g * hi2[1]; }
                        else { const v2u y2 = yv[r][k][j]; x[j][0] += g * bflo(y2.x); x[j][1] += g * bfhi(y2.x); x[j][2] += g * bflo(y2.y); x[j][3] += g * bfhi(y2.y); } }
                    s += (x[j][0] + x[j][1]) + (x[j][2] + x[j][3]); }
                const float mean = wave_sum(s) * (1.0f / 1024.0f); float q = 0.f;
#pragma unroll
                for (int j = 0; j < 4; ++j) { x[j] = x[j] - mean; q += (x[j][0] * x[j][0] + x[j][1] * x[j][1]) + (x[j][2] * x[j][2] + x[j][3] * x[j][3]); }
                const float rstd = 1.0f / sqrtf(wave_sum(q) * (1.0f / 1024.0f) + LN_EPS);
#pragma unroll
                for (int j = 0; j < 4; ++j) { const f32x4 y = x[j] * rstd * gm[j] + bt[j];
                    if (outf) __builtin_nontemporal_store(y, (GAS f32x4*)(outf + rb + 256 * j));
                    if (hb) { v2u o; o.x = pk2(y[0], y[1]); o.y = pk2(y[2], y[3]); *(GAS v2u*)(hb + rb + 256 * j) = o; } }
            }
        }
    }
}

__device__ __forceinline__ void phase_subln(const bf16* oatt, const float* lam4  , const float* subg  , float lambda_init, bf16* od, int vcu, int G, int wv) {
    const int tid = tid_opaque(wv), lane = tid & 63, wave = wv;
    const float a = wave_sum(lam4[lane] * lam4[64 + lane]), b = wave_sum(lam4[128 + lane] * lam4[192 + lane]);
    const float lam = __expf(a) - __expf(b) + lambda_init;
    const int h = lane >> 3, c0 = (lane & 7) * 16;
    float gsc[16];
#pragma unroll
    for (int j = 0; j < 16; ++j) gsc[j] = subg[c0 + j] * (1.0f - lambda_init);
    const int gw = vcu * NWAVES + wave, NGW = G * NWAVES;
    for (int t = gw; t < T; t += NGW) {
        const bf16* p0 = oatt + (size_t)t * 2048 + (2 * h) * 128 + c0; const bf16* p1 = p0 + 128;
        const v4u a0 = *(const v4u*)p0, a1 = *(const GAS v4u*)(p0 + 8), b0 = *(const v4u*)p1, b1 = *(const GAS v4u*)(p1 + 8);
        float o[16];
        o[0] = bflo(a0.x) - lam * bflo(b0.x); o[1] = bfhi(a0.x) - lam * bfhi(b0.x); o[2] = bflo(a0.y) - lam * bflo(b0.y); o[3] = bfhi(a0.y) - lam * bfhi(b0.y);
        o[4] = bflo(a0.z) - lam * bflo(b0.z); o[5] = bfhi(a0.z) - lam * bfhi(b0.z); o[6] = bflo(a0.w) - lam * bflo(b0.w); o[7] = bfhi(a0.w) - lam * bfhi(b0.w);
        o[8] = bflo(a1.x) - lam * bflo(b1.x); o[9] = bfhi(a1.x) - lam * bfhi(b1.x); o[10] = bflo(a1.y) - lam * bflo(b1.y); o[11] = bfhi(a1.y) - lam * bfhi(b1.y);
        o[12] = bflo(a1.z) - lam * bflo(b1.z); o[13] = bfhi(a1.z) - lam * bfhi(b1.z); o[14] = bflo(a1.w) - lam * bflo(b1.w); o[15] = bfhi(a1.w) - lam * bfhi(b1.w);
        float q = 0.f;
#pragma unroll
        for (int j = 0; j < 16; ++j) q += o[j] * o[j];
        q += __shfl_xor(q, 1); q += __shfl_xor(q, 2); q += __shfl_xor(q, 4);
        const float rs = 1.0f / sqrtf(q * (1.0f / 128.0f) + LN_EPS);
        v4u w0, w1;
        w0.x = pk2(o[0] * rs * gsc[0], o[1] * rs * gsc[1]); w0.y = pk2(o[2] * rs * gsc[2], o[3] * rs * gsc[3]); w0.z = pk2(o[4] * rs * gsc[4], o[5] * rs * gsc[5]); w0.w = pk2(o[6] * rs * gsc[6], o[7] * rs * gsc[7]);
        w1.x = pk2(o[8] * rs * gsc[8], o[9] * rs * gsc[9]); w1.y = pk2(o[10] * rs * gsc[10], o[11] * rs * gsc[11]); w1.z = pk2(o[12] * rs * gsc[12], o[13] * rs * gsc[13]); w1.w = pk2(o[14] * rs * gsc[14], o[15] * rs * gsc[15]);
        bf16* q0 = od + (size_t)t * 1024 + h * 128 + c0;
        *(v4u*)q0 = w0; *(GAS v4u*)(q0 + 8) = w1;
    }
}
__device__ __forceinline__ float ret_log2g(int h) {
    return h == 0 ? -0.04580368961312479f : h == 1 ? -0.02272007650008353f : h == 2 ? -0.011315313227834146f : h == 3 ? -0.005646563141142062f :
           h == 4 ? -0.002820519062378663f : h == 5 ? -0.0014095702546713536f : h == 6 ? -0.0007046129765893728f : -0.00035226347162902144f;
}
typedef short v4i16_t __attribute__((ext_vector_type(4)));
__device__ __forceinline__ s16x4 ds_tr(const LAS unsigned char* p) { return __builtin_bit_cast(s16x4, __builtin_amdgcn_ds_read_tr16_b64_v4i16((LAS v4i16_t*)p)); }
__device__ __forceinline__ bf16x8 cat8(s16x4 lo, s16x4 hi) { return (bf16x8){lo[0], lo[1], lo[2], lo[3], hi[0], hi[1], hi[2], hi[3]}; }
__device__ __forceinline__ int crow16(int r, int hi) { return (r & 3) + 8 * (r >> 2) + 4 * hi; }
#define MFMA32(a, b, c) __builtin_amdgcn_mfma_f32_32x32x16_bf16((a), (b), (c), 0, 0, 0)
constexpr int RKS = 272, RVS = 528;
constexpr int R_KOFF = 0, R_BOFF = 128 * RKS;
static_assert(R_BOFF + 256 * RKS <= RING_BYTES && R_BOFF + 128 * RVS <= RING_BYTES, "retention LDS");

__device__ __forceinline__ void phase_RA(LAS unsigned char* lds, const bf16* proj_, bf16* kvt_, int vcu, int G, int wv) {
    const int tid = tid_opaque(wv), w = wv;
    const GAS bf16* proj = (const GAS bf16*)proj_; GAS bf16* kvt = (GAS bf16*)kvt_;
    constexpr int NU = NBATCH * RH * RNCH;
    v4u kreg[4], vreg[8];
#define RA_ISSUE(u_) do { int tl_ = tid; asm volatile("" : "+v"(tl_)); const int bh_ = (u_) >> 6, n_ = (u_) & 63, b_ = bh_ >> 3, h_ = bh_ & 7; const GAS bf16* pb_ = proj + ((size_t)b_ * SEQ + (size_t)n_ * RC_) * 6144 + h_ * 128; \
        _Pragma("unroll") for (int i = 0; i < 4; ++i) { const unsigned c = tl_ + 512 * i, m = c >> 4, ch = c & 15; kreg[i] = *(const GAS v4u*)(pb_ + (m * 6144u + 1024u + ch * 8u)); } \
        _Pragma("unroll") for (int i = 0; i < 8; ++i) { const unsigned c = tl_ + 512 * i, m = c >> 5, ch = c & 31; vreg[i] = *(const GAS v4u*)(pb_ + (m * 6144u + 2048u + h_ * 128u + ch * 8u)); } } while (0)
    if (vcu < NU) RA_ISSUE(vcu);
    for (int unit = vcu; unit < NU; unit += G) {
        const int h = (unit >> 6) & 7; const float l2g = ret_log2g(h);
        int tl = tid; asm volatile("" : "+v"(tl));
        const int lane = tl & 63, r32 = lane & 31, hi = lane >> 5, blk = (lane >> 4) & 1, q = (lane & 15) >> 2, p = lane & 3;
        __syncthreads();
#pragma unroll
        for (int i = 0; i < 4; ++i) { const int c = tl + 512 * i, m = c >> 4, ch = c & 15; const v4u v = kreg[i]; const float dk = __builtin_amdgcn_exp2f((float)(127 - m) * l2g);
            v4u o; o.x = pk2(bflo(v.x) * dk, bfhi(v.x) * dk); o.y = pk2(bflo(v.y) * dk, bfhi(v.y) * dk); o.z = pk2(bflo(v.z) * dk, bfhi(v.z) * dk); o.w = pk2(bflo(v.w) * dk, bfhi(v.w) * dk);
            *(LAS v4u*)(lds + R_KOFF + m * RKS + ch * 16) = o; }
#pragma unroll
        for (int i = 0; i < 8; ++i) { const int c = tl + 512 * i, m = c >> 5, ch = c & 31; *(LAS v4u*)(lds + R_BOFF + m * RVS + ch * 16) = vreg[i]; }
        __syncthreads();
        if (unit + G < NU) RA_ISSUE(unit + G);
        const int dt = w & 3, e0 = 128 * (w >> 2);
        f32x16 acc[4];
#pragma unroll
        for (int c = 0; c < 4; ++c)
#pragma unroll
            for (int r = 0; r < 16; ++r) acc[c][r] = 0.f;
#pragma unroll
        for (int ks = 0; ks < 8; ++ks) {
            const LAS unsigned char* ka = lds + R_KOFF + (16 * ks + 8 * hi + q) * RKS + (32 * dt + 16 * blk + 4 * p) * 2;
            const bf16x8 af = cat8(ds_tr(ka), ds_tr(ka + 4 * RKS));
#pragma unroll
            for (int c = 0; c < 4; ++c) {
                const LAS unsigned char* va = lds + R_BOFF + (16 * ks + 8 * hi + q) * RVS + (e0 + 32 * c + 16 * blk + 4 * p) * 2;
                const bf16x8 bfr = cat8(ds_tr(va), ds_tr(va + 4 * RVS));
                acc[c] = MFMA32(af, bfr, acc[c]); }
            __builtin_amdgcn_sched_barrier(0);
        }
#if RET_F8
        GAS unsigned char* o8 = (GAS unsigned char*)kvt + (size_t)unit * 32768;
#pragma unroll
        for (int c = 0; c < 4; ++c)
#pragma unroll
            for (int g = 0; g < 4; ++g) { int w8 = __builtin_amdgcn_cvt_pk_fp8_f32(acc[c][4 * g] * RET_KS, acc[c][4 * g + 1] * RET_KS, 0, false); w8 = __builtin_amdgcn_cvt_pk_fp8_f32(acc[c][4 * g + 2] * RET_KS, acc[c][4 * g + 3] * RET_KS, w8, true);
                *(GAS int*)(o8 + ((e0 + 32 * c + r32) * 128 + 32 * dt + 8 * g + 4 * hi)) = w8; }
#else
        GAS bf16* o = kvt + (size_t)unit * 32768;
#pragma unroll
        for (int c = 0; c < 4; ++c)
#pragma unroll
            for (int g = 0; g < 4; ++g) { v2u pw; pw.x = pk2(acc[c][4 * g], acc[c][4 * g + 1]); pw.y = pk2(acc[c][4 * g + 2], acc[c][4 * g + 3]);
                *(GAS v2u*)(o + ((e0 + 32 * c + r32) * 128 + 32 * dt + 8 * g + 4 * hi)) = pw; }
#endif
    }
#undef RA_ISSUE
}

__device__ __forceinline__ void phase_RB(const bf16* kvt, bf16* state, int vcu, int G, int wv) {
    const int gt = vcu * (NWAVES * 64) + tid_opaque(wv), NGT = G * NWAVES * 64;
    typedef float f32x2r __attribute__((ext_vector_type(2)));
    for (int i = gt; i < NBATCH * RH * 4096; i += NGT) {
        const int bh = i >> 12, qd = i & 4095; const float dec = __builtin_amdgcn_exp2f(128.0f * ret_log2g(bh & 7));
#if RET_F8
        const GAS unsigned char* src = (const GAS unsigned char*)kvt + (size_t)bh * 64 * 32768 + (size_t)qd * 8; GAS unsigned char* dst = (GAS unsigned char*)state + (size_t)bh * 64 * 32768 + (size_t)qd * 8;
        float st[8];
#pragma unroll
        for (int k = 0; k < 8; ++k) st[k] = 0.f;
        v2u kvn[8];
#pragma unroll
        for (int j = 0; j < 8; ++j) kvn[j] = *(const GAS v2u*)(src + (size_t)j * 32768);
        for (int n0 = 0; n0 < 64; n0 += 8) {
            v2u kv[8];
#pragma unroll
            for (int j = 0; j < 8; ++j) kv[j] = kvn[j];
            if (n0 + 8 < 64) {
#pragma unroll
                for (int j = 0; j < 8; ++j) kvn[j] = *(const GAS v2u*)(src + (size_t)(n0 + 8 + j) * 32768); }
#pragma unroll
            for (int j = 0; j < 8; ++j) { int o0 = __builtin_amdgcn_cvt_pk_fp8_f32(st[0], st[1], 0, false); o0 = __builtin_amdgcn_cvt_pk_fp8_f32(st[2], st[3], o0, true);
                int o1 = __builtin_amdgcn_cvt_pk_fp8_f32(st[4], st[5], 0, false); o1 = __builtin_amdgcn_cvt_pk_fp8_f32(st[6], st[7], o1, true);
                *(GAS v2u*)(dst + (size_t)(n0 + j) * 32768) = (v2u){(unsigned)o0, (unsigned)o1};
                const f32x2r a0 = __builtin_amdgcn_cvt_pk_f32_fp8((int)kv[j].x, false), a1 = __builtin_amdgcn_cvt_pk_f32_fp8((int)kv[j].x, true), a2 = __builtin_amdgcn_cvt_pk_f32_fp8((int)kv[j].y, false), a3 = __builtin_amdgcn_cvt_pk_f32_fp8((int)kv[j].y, true);
                st[0] = st[0] * dec + a0[0]; st[1] = st[1] * dec + a0[1]; st[2] = st[2] * dec + a1[0]; st[3] = st[3] * dec + a1[1];
                st[4] = st[4] * dec + a2[0]; st[5] = st[5] * dec + a2[1]; st[6] = st[6] * dec + a3[0]; st[7] = st[7] * dec + a3[1]; }
        }
#else
        const GAS bf16* src = (const GAS bf16*)kvt + (size_t)bh * 64 * 32768 + (size_t)qd * 8; GAS bf16* dst = (GAS bf16*)state + (size_t)bh * 64 * 32768 + (size_t)qd * 8;
        float st[8];
#pragma unroll
        for (int k = 0; k < 8; ++k) st[k] = 0.f;
        v4u kvn[8];
#pragma unroll
        for (int j = 0; j < 8; ++j) kvn[j] = *(const GAS v4u*)(src + (size_t)j * 32768);
        for (int n0 = 0; n0 < 64; n0 += 8) {
            v4u kv[8];
#pragma unroll
            for (int j = 0; j < 8; ++j) kv[j] = kvn[j];
            if (n0 + 8 < 64) {
#pragma unroll
                for (int j = 0; j < 8; ++j) kvn[j] = *(const GAS v4u*)(src + (size_t)(n0 + 8 + j) * 32768); }
#pragma unroll
            for (int j = 0; j < 8; ++j) { v4u o; o.x = pk2(st[0], st[1]); o.y = pk2(st[2], st[3]); o.z = pk2(st[4], st[5]); o.w = pk2(st[6], st[7]); *(GAS v4u*)(dst + (size_t)(n0 + j) * 32768) = o;
                st[0] = st[0] * dec + bflo(kv[j].x); st[1] = st[1] * dec + bfhi(kv[j].x); st[2] = st[2] * dec + bflo(kv[j].y); st[3] = st[3] * dec + bfhi(kv[j].y);
                st[4] = st[4] * dec + bflo(kv[j].z); st[5] = st[5] * dec + bfhi(kv[j].z); st[6] = st[6] * dec + bflo(kv[j].w); st[7] = st[7] * dec + bfhi(kv[j].w); }
        }
#endif
    }
}

__device__ __forceinline__ void phase_RC(LAS unsigned char* lds, const bf16* proj_, const bf16* state_, bf16* og_, int vcu, int G, int wv) {
    const int tid = tid_opaque(wv), w = wv;
    const int qb = w & 3, eh = w >> 2;
    const GAS bf16* proj = (const GAS bf16*)proj_; const GAS bf16* state = (const GAS bf16*)state_; GAS bf16* og = (GAS bf16*)og_;
    constexpr int NU = NBATCH * RH * RNCH;
    v4u kreg[4], sreg[RET_F8 ? 4 : 8], vreg[8]; bf16x8 qf[8]; v2u greg[16];
#define RC_ISSUE(u_) do { int tl_ = tid; asm volatile("" : "+v"(tl_)); const int bh_ = (u_) >> 6, n_ = (u_) & 63, b_ = bh_ >> 3, h_ = bh_ & 7; const GAS bf16* pb_ = proj + ((size_t)b_ * SEQ + (size_t)n_ * RC_) * 6144 + h_ * 128; const GAS bf16* sb_ = state + (size_t)(u_) * 32768; const GAS unsigned char* sb8_ = (const GAS unsigned char*)state + (size_t)(u_) * 32768; (void)sb_; (void)sb8_; \
        _Pragma("unroll") for (int i = 0; i < 4; ++i) { const unsigned c = tl_ + 512 * i, m = c >> 4, ch = c & 15; kreg[i] = *(const GAS v4u*)(pb_ + (m * 6144u + 1024u + ch * 8u)); } \
        if (RET_F8) { _Pragma("unroll") for (int i = 0; i < 4; ++i) { const unsigned c = tl_ + 512 * i; sreg[i] = *(const GAS v4u*)(sb8_ + c * 16u); } } \
        else { _Pragma("unroll") for (int i = 0; i < (RET_F8 ? 4 : 8); ++i) { const unsigned c = tl_ + 512 * i; sreg[i] = *(const GAS v4u*)(sb_ + c * 8u); } } \
        _Pragma("unroll") for (int ks = 0; ks < 8; ++ks) qf[ks] = *(const GAS bf16x8*)(pb_ + ((32u * qb + (tl_ & 31)) * 6144u + 16u * ks + 8u * ((tl_ >> 5) & 1))); } while (0)
    if (vcu < NU) RC_ISSUE(vcu);
    for (int unit = vcu; unit < NU; unit += G) {
        const int bh = unit >> 6, n = unit & 63, b = bh >> 3, h = bh & 7; const float l2g = ret_log2g(h);
        const size_t t0 = (size_t)b * SEQ + (size_t)n * RC_;
        int tl = tid; asm volatile("" : "+v"(tl));
        const int lane = tl & 63, r32 = lane & 31, hi = lane >> 5, blk = (lane >> 4) & 1, q = (lane & 15) >> 2, p = lane & 3;
        __syncthreads();
#pragma unroll
        for (int i = 0; i < 4; ++i) { const int c = tl + 512 * i, m = c >> 4, ch = c & 15; *(LAS v4u*)(lds + R_KOFF + m * RKS + ch * 16) = kreg[i]; }
#pragma unroll
        for (int i = 0; i < (RET_F8 ? 4 : 8); ++i) {
            if (RET_F8) { const int c = tl + 512 * i, e = c >> 3, ch = c & 7; const v4u s8 = sreg[i]; typedef float f32x2r __attribute__((ext_vector_type(2)));
                unsigned wd[8];
#pragma unroll
                for (int k = 0; k < 4; ++k) { const int w8 = (int)(k == 0 ? s8.x : k == 1 ? s8.y : k == 2 ? s8.z : s8.w); const f32x2r lo2 = __builtin_amdgcn_cvt_pk_f32_fp8(w8, false), hi2 = __builtin_amdgcn_cvt_pk_f32_fp8(w8, true); wd[2 * k] = pk2(lo2[0], lo2[1]); wd[2 * k + 1] = pk2(hi2[0], hi2[1]); }
                *(LAS v4u*)(lds + R_BOFF + e * RKS + ch * 32) = (v4u){wd[0], wd[1], wd[2], wd[3]}; *(LAS v4u*)(lds + R_BOFF + e * RKS + ch * 32 + 16) = (v4u){wd[4], wd[5], wd[6], wd[7]}; }
            else { const int c = tl + 512 * i, e = c >> 4, ch = c & 15; *(LAS v4u*)(lds + R_BOFF + e * RKS + ch * 16) = sreg[i]; } }
        __syncthreads();
        const GAS bf16* pb = proj + t0 * 6144 + h * 128;
#pragma unroll
        for (int i = 0; i < 8; ++i) { const unsigned c = tl + 512 * i, m = c >> 5, ch = c & 31; vreg[i] = *(const GAS v4u*)(pb + (m * 6144u + 2048u + h * 128u + ch * 8u)); }
        f32x16 acc[4];
#pragma unroll
        for (int c = 0; c < 4; ++c)
#pragma unroll
            for (int r = 0; r < 16; ++r) acc[c][r] = 0.f;
#pragma unroll
        for (int ks = 0; ks < 8; ++ks)
#pragma unroll
            for (int ct = 0; ct < 4; ++ct) {
                const bf16x8 bs = *(const LAS bf16x8*)(lds + R_BOFF + (128 * eh + 32 * ct + r32) * RKS + (16 * ks + 8 * hi) * 2);
                acc[ct] = MFMA32(qf[ks], bs, acc[ct]); if (ct == 3) __builtin_amdgcn_sched_barrier(0); }
#pragma unroll
        for (int r = 0; r < 16; ++r) { const float qd = __builtin_amdgcn_exp2f((float)(32 * qb + crow16(r, hi) + 1) * l2g) * (RET_F8 ? 1.0f / RET_KS : 1.0f);
#pragma unroll
            for (int ct = 0; ct < 4; ++ct) acc[ct][r] *= qd; }
        __syncthreads();
#pragma unroll
        for (int i = 0; i < 8; ++i) { const int c = tl + 512 * i, m = c >> 5, ch = c & 31; *(LAS v4u*)(lds + R_BOFF + m * RVS + ch * 16) = vreg[i]; }
        __syncthreads();
        for (int kb = 0; kb <= qb; ++kb) {
            f32x16 xs;
#pragma unroll
            for (int r = 0; r < 16; ++r) xs[r] = 0.f;
#pragma unroll
            for (int ks = 0; ks < 8; ++ks) {
                const bf16x8 kf = *(const LAS bf16x8*)(lds + R_KOFF + (32 * kb + r32) * RKS + (16 * ks + 8 * hi) * 2);
                xs = MFMA32(kf, qf[ks], xs); }
            const int qpos = 32 * qb + r32;
#pragma unroll
            for (int r = 0; r < 16; ++r) { const int df = qpos - (32 * kb + crow16(r, hi)); xs[r] = df >= 0 ? xs[r] * __builtin_amdgcn_exp2f((float)df * l2g) : 0.f; }
#pragma unroll
            for (int s = 0; s < 2; ++s) {
                v4u pw; pw.x = pk2(xs[8 * s], xs[8 * s + 1]); pw.y = pk2(xs[8 * s + 2], xs[8 * s + 3]); pw.z = pk2(xs[8 * s + 4], xs[8 * s + 5]); pw.w = pk2(xs[8 * s + 6], xs[8 * s + 7]);
                const bf16x8 pf = __builtin_bit_cast(bf16x8, pw);
#pragma unroll
                for (int ct = 0; ct < 4; ++ct) {
                    const LAS unsigned char* va = lds + R_BOFF + (32 * kb + 16 * s + 4 * hi + q) * RVS + (128 * eh + 32 * ct + 16 * blk + 4 * p) * 2;
                    const bf16x8 vf = cat8(ds_tr(va), ds_tr(va + 8 * RVS));
                    acc[ct] = MFMA32(pf, vf, acc[ct]); }
                __builtin_amdgcn_sched_barrier(0);
            }
        }
#pragma unroll
        for (int i = 0; i < 16; ++i) greg[i] = *(const GAS v2u*)(pb + ((w * 16u + i) * 6144u + 4096u + h * 128u + 4u * lane));
        __syncthreads();
        LAS float* ot = (LAS float*)lds;
#pragma unroll
        for (int ct = 0; ct < 4; ++ct)
#pragma unroll
            for (int r = 0; r < 16; ++r) ot[(32 * qb + crow16(r, hi)) * 256 + 128 * eh + 32 * ct + r32] = acc[ct][r];
        __syncthreads();
        if (unit + G < NU) RC_ISSUE(unit + G);
#pragma unroll
        for (int i = 0; i < 16; ++i) { const int c = w * 16 + i;
            const f32x4 v = *(const LAS f32x4*)(ot + c * 256 + 4 * lane);
            const float mean = wave_sum((v[0] + v[1]) + (v[2] + v[3])) * (1.0f / 256.0f);
            const f32x4 d = v - mean; const float var = wave_sum((d[0] * d[0] + d[1] * d[1]) + (d[2] * d[2] + d[3] * d[3])) * (1.0f / 256.0f);
            const float rs = 1.0f / sqrtf(var + LN_EPS);
            const v2u gv = greg[i];
            v2u o; o.x = pk2(d[0] * rs * bflo(gv.x), d[1] * rs * bfhi(gv.x)); o.y = pk2(d[2] * rs * bflo(gv.y), d[3] * rs * bfhi(gv.y));
            *(GAS v2u*)(og + t0 * 2048 + (c * 2048u + h * 256u + 4u * lane)) = o; if (i & 1) __builtin_amdgcn_sched_barrier(0); }
    }
#undef RC_ISSUE
}
#ifndef MK_SPLIT
#define MK_SPLIT 0
#endif
#ifndef ALIGN_U
#define ALIGN_U true
#endif
#ifndef KREP_U
#define KREP_U 1
#endif
#ifndef KREP_D
#define KREP_D 1
#endif
#ifndef PH_MASK
#define PH_MASK 0xFFFF
#endif
#define PHM(b) constexpr ((PH_MASK >> (b)) & 1)
#ifndef REP_MASK
#define REP_MASK 0
#endif
#define REP(b) for (int rep_ = 0; rep_ < 1 + (int)(((unsigned)REP_MASK >> (b)) & 1u); ++rep_)
constexpr int N_PHASE_IDS = 1 + 9 * DEPTH;
constexpr float ATTN_C2 = 0.18033688011112042f;

__global__ void __launch_bounds__(NWAVES * 64, 2) yoco_fwd(Ptrs P) {
    extern __shared__ __attribute__((aligned(16))) unsigned char lds[];
    LAS unsigned char* L = (LAS unsigned char*)lds;
    volatile LAS unsigned* MISC = (volatile LAS unsigned*)(L + LDSCTL_OFF);
    LAS unsigned long long* PTW = (LAS unsigned long long*)(L + LDSCTL_OFF + 64);
    const LAS unsigned long long* PT = PTW;
    const int tid = threadIdx.x;
    const int G = gridDim.x; int vcu; { const int bx = blockIdx.x; vcu = (G % 8 == 0) ? (bx % 8) * (G / 8) + bx / 8 : bx; }
    for (int u = tid; u < 128; u += NWAVES * 64) ((LAS unsigned*)(L + LDSCTL_OFF))[u] = 0u;
    __syncthreads();
    if ((tid & 63) == 0) ((LAS unsigned*)(L + LDSCTL_OFF + 256))[(unsigned)__builtin_amdgcn_s_getreg((5 << 11) | 4) & 63u] = (unsigned)(tid >> 6);
    if (tid == 0) {
        PTW[PI_X] = (unsigned long long)P.x; PTW[PI_RET_W_IN] = (unsigned long long)P.ret_w_in; PTW[PI_RET_W_OUT] = (unsigned long long)P.ret_w_out; PTW[PI_KV_W] = (unsigned long long)P.kv_w;
        PTW[PI_DIFF_W_Q] = (unsigned long long)P.diff_w_q; PTW[PI_DIFF_LAMBDA] = (unsigned long long)P.diff_lambda; PTW[PI_DIFF_SUBLN_G] = (unsigned long long)P.diff_subln_g; PTW[PI_DIFF_W_OUT] = (unsigned long long)P.diff_w_out;
        PTW[PI_LN_ATTN_G] = (unsigned long long)P.ln_attn_g; PTW[PI_LN_ATTN_B] = (unsigned long long)P.ln_attn_b; PTW[PI_LN_FFN_G] = (unsigned long long)P.ln_ffn_g; PTW[PI_LN_FFN_B] = (unsigned long long)P.ln_ffn_b;
        PTW[PI_W_ROUTER] = (unsigned long long)P.moe_w_router; PTW[PI_B_ROUTER] = (unsigned long long)P.moe_b_router; PTW[PI_W_UP] = (unsigned long long)P.moe_w_up; PTW[PI_B_UP] = (unsigned long long)P.moe_b_up;
        PTW[PI_W_DOWN] = (unsigned long long)P.moe_w_down; PTW[PI_B_DOWN] = (unsigned long long)P.moe_b_down; PTW[PI_OUT] = (unsigned long long)P.out; PTW[PI_WS] = (unsigned long long)P.ws;
    }
#if MK_SPLIT
    const int lo = P.ph_lo, hi = P.ph_hi; const int bar_li = P.li;
#else
    constexpr int lo = 0, hi = N_PHASE_IDS, bar_li = 0;
#endif
    (void)xcd_barrier_post((unsigned*)((gu32*)(P.ws + WS_CTL) + CW_BAR) + (size_t)bar_li * XCD_BAR_WORDS, MISC + 8, 0);
    __syncthreads();
#define IN(k) (lo <= (k) && (k) < hi)
#define SEAM(k) do { if ((k) + 1 < hi) { XcdBarrier bar_; bar_.bar = (unsigned*)((gu32*)((unsigned char*)ldp_raw(PT, PI_WS) + WS_CTL) + CW_BAR) + (size_t)bar_li * XCD_BAR_WORDS; bar_.x = xb_xcc_id(); bar_.st = (volatile LAS unsigned*)(L + LDSCTL_OFF) + 8; bar_.wv = 0; \
        xcd_barrier(bar_); if ((REP_MASK >> 15) & 1) xcd_barrier(bar_); } } while (0)
#define SITE_WS() unsigned char* const ws = (unsigned char*)ldp_raw(PT, PI_WS); const int wv = wave_index()

    if PHM(0) if (IN(0)) REP(0) { phase_prologue(L, PT, vcu, G, wave_index()); SEAM(0); }

    for (int l = 0; l < DEPTH; ++l) {
        const int pb = 1 + 9 * l;
        if PHM(1) if (IN(pb + 0)) REP(1) {
            SITE_WS(); const bf16* hb = (const bf16*)(ws + WS_HB);
            if (l < 2) { if PHM(12) {
                pg8::Gemm g{hb, (const bf16*)(ws + WS_WIN) + (size_t)l * 6144 * 1024, 1024, wv}; pg8::StaticOrder S; S.init(T, 6144, G, (int)blockIdx.x);
                pg8::EpiRetIn E{(bf16*)(ws + WS_PROJ), (const float*)(ws + WS_ROPE_R), (const float*)(ws + WS_ROPE_R) + SEQ * 64};
                pg8::gemm_phase<pg8::EpiRetIn, pg8::StaticOrder, true, true>(L, g, S, E); }
            } else if PHM(13) {
                const int N = (l == 2) ? 3072 : 1024;
                pg8::Gemm g{hb, (const bf16*)(ws + ((l == 2) ? WS_WKV : WS_WQ + (size_t)1024 * 1024 * 2)), 1024, wv}; pg8::StaticOrder S; S.init(T, N, G, (int)blockIdx.x);
                typedef pg8::EpiDiffQK<(long)(WS_KSH / 2), (long)(WS_VSH / 2), (long)(WS_QD / 2)> EpiQKV; EpiQKV E{(bf16*)ws, (l == 2) ? 0 : 8, ATTN_C2, (const float*)(ws + WS_ROPE_D), (const float*)(ws + WS_ROPE_D) + SEQ * 8};
                pg8::gemm_phase<EpiQKV, pg8::StaticOrder, true, true>(L, g, S, E);
            }
            SEAM(pb + 0);
        }
        if (IN(pb + 1)) REP(l < 2 ? 2 : 3) {
            SITE_WS();
            if (l < 2) { if PHM(2) phase_RA(L, (const bf16*)(ws + WS_PROJ), (bf16*)(ws + WS_KVT), vcu, G, wv); }
            else if PHM(3) { const attn_body::AttnTensors AT{(const attn_body::bf16*)(ws + WS_QD), (const attn_body::bf16*)(ws + WS_KSH), (const attn_body::bf16*)(ws + WS_VSH), (attn_body::bf16*)(ws + WS_OATT), wv,
                       (attn_body::bf16*)(ws + WS_OD), LDPF(PI_DIFF_LAMBDA) + (size_t)(l - 2) * 256, LDPF(PI_DIFF_SUBLN_G) + (size_t)(l - 2) * 128, l == 2 ? 0.4707130183435842f : 0.5560582041556406f};
                   const attn_body::DiffOrder S(vcu);
#if CONV_IN_ATTN
                   const ConvHook H{PT, L, l, vcu * NWAVES + wv, G * NWAVES, wv}; attn_body::attn_phase<attn_body::DiffOrder, ConvHook>((char*)lds, AT, S, H);
#else
                   attn_body::attn_phase<attn_body::DiffOrder, NoHook>((char*)lds, AT, S, NoHook{});
#endif
                 }
            SEAM(pb + 1);
        }
        if (IN(pb + 2) && l < 2) REP(4) {
            SITE_WS();
            if PHM(4) phase_RB((const bf16*)(ws + WS_KVT), (bf16*)(ws + WS_STATE), vcu, G, wv);
            SEAM(pb + 2);
        }
        if PHM(6) if (IN(pb + 3) && l < 2) REP(6) { SITE_WS(); phase_RC(L, (const bf16*)(ws + WS_PROJ), (const bf16*)(ws + WS_STATE), (bf16*)(ws + WS_OG), vcu, G, wv); SEAM(pb + 3); }
        if PHM(7) if (IN(pb + 4)) REP(7) {
            SITE_WS();
            const int K = (l < 2) ? 2048 : 1024;
            const size_t aoff_ = (l < 2) ? WS_OG : WS_OD, boff_ = (l < 2) ? WS_WROUT + (size_t)l * 1024 * 2048 * 2 : WS_WDOUT + (size_t)(l - 2) * 1024 * 1024 * 2;
            pg8::Gemm g{(const bf16*)(ws + aoff_), (const bf16*)(ws + boff_), K, wv};
            pg8::StaticOrder S; S.init(T, 1024, G, (int)blockIdx.x);
            pg8::EpiBf16Res E{(const bf16*)(ws + WS_HB), (bf16*)(ws + WS_SBUF), DN_ALPHA};
            pg8::gemm_phase<pg8::EpiBf16Res, pg8::StaticOrder, true, true>(L, g, S, E);
            SEAM(pb + 4);
        }
        if PHM(8) if (IN(pb + 5)) REP(8) {
            SITE_WS();
            const bool dummy = (rep_ == 0) && ((REP_MASK >> 8) & 1);
            phase_R(L, (const bf16*)(ws + WS_SBUF), LDPF(PI_LN_ATTN_G) + l * 1024, LDPF(PI_LN_ATTN_B) + l * 1024, (bf16*)(ws + WS_HB), (unsigned char*)(ws + WS_HQ), (const bf16*)(ws + WS_WRT) + (size_t)l * 2 * 32 * 1024, LDPF(PI_B_ROUTER) + l * 32,
                    (unsigned*)(ws + WS_CTL) + CW_CNT + l * 64 + (dummy ? 32 : 0), (int*)(ws + (dummy ? WS_Y : WS_ROWTOK)), (int*)(ws + (dummy ? WS_Y + 8 * MiB : WS_TOKE)), (int*)(ws + (dummy ? WS_Y + 9 * MiB : WS_TOKR)), (float*)(ws + (dummy ? WS_Y + 10 * MiB : WS_TOKG)), (float*)(ws + (dummy ? WS_Y + 11 * MiB : WS_HF)), vcu, G, wv);
            SEAM(pb + 5);
        }
        if PHM(9) if (IN(pb + 6)) REP(9) {
            SITE_WS(); const unsigned* gcnt = (const unsigned*)(ws + WS_CTL) + CW_CNT + l * 64; const GAS int* row_tok = (const GAS int*)(ws + WS_ROWTOK);
            moe_tables(L, gcnt, wv);
            const LAS int* tile_e = (const LAS int*)(L + TAB_TILE_E); const LAS int* tstart = (const LAS int*)(L + TAB_TSTART); LAS int* rowtab = (LAS int*)(L + TAB_ROWTAB);
            const int NT = __builtin_amdgcn_readfirstlane(tstart[32]); const int NX = G >> 5, TPX = (NT + NX - 1) / NX;
            const int LU = TPX & 3, NFULL = TPX >> 2;
            for (int part = 0; part < (LU ? 2 : 1); ++part) {
            pg8::MoeOrder<true> S{vcu, G, NT, 8, TPX, tile_e, rowtab, part ? NFULL * 32 : 0, part ? TPX * 8 : NFULL * 32};
            { const int t0_ = tid_opaque(wv); int tokv[9];
#pragma unroll
              for (int k = 0; k < 9; ++k) { const int idx = t0_ + k * NWAVES * 64; tokv[k] = 0; const int rt = S.tile_of(idx >> 8);
                  if ((idx >> 8) < 18 && rt < NT) { const int r = idx & 255, e = tile_e[rt]; const int rr = (rt - tstart[e]) * 256 + r; if (rr < tstart[64 + e]) tokv[k] = row_tok[(size_t)e * CAP + rr]; } }
#pragma unroll
              for (int k = 0; k < 9; ++k) { const int idx = t0_ + k * NWAVES * 64; if ((idx >> 8) < 18) rowtab[idx] = tokv[k]; } }
            __syncthreads();
            pg8::Gemm g{(const bf16*)(ws + (MOE_FP8 ? WS_HQ : WS_HB)), (const bf16*)(ws + WS_WUP + (size_t)l * 32 * 2048 * 1024 * (MOE_FP8 ? 1 : 2)), MOE_FP8 ? 512 : 1024, wv};
            pg8::EpiSwiglu<MOE_FP8> E{(void*)(ws + WS_HDN), LDPF(PI_B_UP) + (size_t)l * 32 * 2048};
            pg8::gemm_phase<pg8::EpiSwiglu<MOE_FP8>, pg8::MoeOrder<true>, true, true, MOE_FP8, KREP_U>(L, g, S, E);
            if (part == 0) SEAM(pb + 6);
            }
        }
        if PHM(10) if (IN(pb + 7)) REP(10) {
            SITE_WS(); const unsigned* gcnt = (const unsigned*)(ws + WS_CTL) + CW_CNT + l * 64;
            moe_tables(L, gcnt, wv);
            const LAS int* tile_e = (const LAS int*)(L + TAB_TILE_E); const LAS int* tstart = (const LAS int*)(L + TAB_TSTART);
            const int NT = __builtin_amdgcn_readfirstlane(tstart[32]); const int NX = G >> 5, TPX = (NT + NX - 1) / NX;
            const int LU = TPX & 3, EARLY = LU ? 32 - 8 * LU : 0;
            for (int part = (LU ? 0 : 1); part < 2; ++part) {
            pg8::MoeOrder<false> S{vcu, G, NT, 4, TPX, tile_e, nullptr, part ? EARLY : EARLY - 32, part ? TPX * 4 : EARLY};
            pg8::Gemm g{(const bf16*)(ws + WS_HDN), (const bf16*)(ws + WS_WDN + (size_t)l * 32 * 1024 * 1024 * (MOE_FP8 ? 1 : 2)), MOE_FP8 ? 512 : 1024, wv};
            pg8::EpiDown<MOE_FP8> E{(void*)(ws + WS_Y), LDPF(PI_B_DOWN) + (size_t)l * 32 * 1024};
            pg8::gemm_phase<pg8::EpiDown<MOE_FP8>, pg8::MoeOrder<false>, false, true, MOE_FP8, KREP_D>(L, g, S, E);
            SEAM(pb + 7);
            }
        }
        if PHM(11) if (IN(pb + 8)) REP(11) {
            SITE_WS();
            const bool dummy = (rep_ == 0) && ((REP_MASK >> 11) & 1);
            float* outp = (l == DEPTH - 1 && !dummy) ? (float*)ldp_raw(PT, PI_OUT) : (float*)nullptr;
            bf16* hbo = dummy ? (bf16*)(ws + WS_SBUF) : ((l == DEPTH - 1) ? (bf16*)nullptr : (bf16*)(ws + WS_HB));
            phase_C(L, (const bf16*)(ws + (MOE_FP8 ? WS_SBUF : WS_HB)), (const float*)(ws + WS_HF), LDPF(PI_LN_ATTN_G) + l * 1024, LDPF(PI_LN_ATTN_B) + l * 1024, (const void*)(ws + WS_Y), (const int*)(ws + WS_TOKE), (const int*)(ws + WS_TOKR), (const float*)(ws + WS_TOKG), (const unsigned*)(ws + WS_CTL) + CW_CNT + l * 64,
                    LDPF(PI_LN_FFN_G) + l * 1024, LDPF(PI_LN_FFN_B) + l * 1024, outp, hbo, vcu, G, wv);
            SEAM(pb + 8);
        }
    }
#undef IN
#undef SEAM
}

extern "C" void kernel_launch(void* const* d_in, const int* in_sizes, int n_in, void* d_out, int out_size, void* d_ws, size_t ws_size, hipStream_t stream) {
    static int grid = 0;
    if (grid == 0) {
        if (n_in != 18 || in_sizes[0] != T * D || out_size != T * D || ws_size < WS_END) { fprintf(stderr, "kernel_launch: unexpected shapes (n_in %d, in0 %d, out %d, ws %zu < %zu); nothing launched\n", n_in, n_in > 0 ? in_sizes[0] : -1, out_size, ws_size, (size_t)WS_END); grid = -1; return; }
        int dev = 0, cus = 0, per_cu = 0;
        if (hipGetDevice(&dev) != hipSuccess || hipDeviceGetAttribute(&cus, hipDeviceAttributeMultiprocessorCount, dev) != hipSuccess) { fprintf(stderr, "kernel_launch: device query failed\n"); grid = -1; return; }
        if (hipFuncSetAttribute((const void*)yoco_fwd, hipFuncAttributeMaxDynamicSharedMemorySize, LDS_BYTES) != hipSuccess) { fprintf(stderr, "kernel_launch: hipFuncSetAttribute failed\n"); grid = -1; return; }
        if (hipOccupancyMaxActiveBlocksPerMultiprocessor(&per_cu, (const void*)yoco_fwd, NWAVES * 64, LDS_BYTES) != hipSuccess || per_cu < 1)
            fprintf(stderr, "kernel_launch: note: occupancy query reports %d workgroups per CU\n", per_cu);
        (void)hipGetLastError();
        grid = cus;
    }
    if (grid < 0) return;
    if (hipMemsetAsync((char*)d_ws + WS_CTL, 0, CTL_ZERO_BYTES, stream) != hipSuccess) { fprintf(stderr, "kernel_launch: hipMemsetAsync failed\n"); return; }
    Ptrs p{};
    p.x = (const float*)d_in[0]; p.ret_w_in = (const float*)d_in[1]; p.ret_w_out = (const float*)d_in[2]; p.kv_w = (const float*)d_in[3]; p.diff_w_q = (const float*)d_in[4];
    p.diff_lambda = (const float*)d_in[5]; p.diff_subln_g = (const float*)d_in[6]; p.diff_w_out = (const float*)d_in[7]; p.ln_attn_g = (const float*)d_in[8]; p.ln_attn_b = (const float*)d_in[9];
    p.ln_ffn_g = (const float*)d_in[10]; p.ln_ffn_b = (const float*)d_in[11]; p.moe_w_router = (const float*)d_in[12]; p.moe_b_router = (const float*)d_in[13]; p.moe_w_up = (const float*)d_in[14];
    p.moe_b_up = (const float*)d_in[15]; p.moe_w_down = (const float*)d_in[16]; p.moe_b_down = (const float*)d_in[17];
    p.out = (float*)d_out; p.ws = (unsigned char*)d_ws;
#if MK_SPLIT
    int li = 0;
    for (int ph = 0; ph < N_PHASE_IDS; ++ph) {
        if (ph >= 1 && ((ph - 1) % 9) == 3 && (ph - 1) / 9 >= 2) continue;
        p.ph_lo = ph; p.ph_hi = ph + 1; p.li = li++; p.pad = 0;
        hipLaunchKernelGGL(yoco_fwd, dim3(grid), dim3(NWAVES * 64), LDS_BYTES, stream, p);
    }
#else
    p.ph_lo = 0; p.ph_hi = N_PHASE_IDS; p.li = 0; p.pad = 0;
    hipLaunchKernelGGL(yoco_fwd, dim3(grid), dim3(NWAVES * 64), LDS_BYTES, stream, p);
#endif
    const hipError_t le = hipPeekAtLastError();
    if (le != hipSuccess) fprintf(stderr, "kernel_launch: launch failed: %s (grid %d)\n", hipGetErrorName(le), grid);
}
```

```cpp
#include <hip/hip_runtime.h>
#include <hip/hip_bf16.h>
#include <cstdio>
#include <cstdint>

#define WAVE_TAB_LDS_OFF (131072 + 256)
__device__ __forceinline__ int wave_index() { const unsigned key = (unsigned)__builtin_amdgcn_s_getreg((5 << 11) | 4) & 63u;
    return __builtin_amdgcn_readfirstlane((int)((const __attribute__((address_space(3))) unsigned*)WAVE_TAB_LDS_OFF)[key]); }
__device__ __forceinline__ int tid_opaque(int wv) { unsigned z = 0u; asm volatile("" : "+v"(z));
    int t = wv * 64 + (int)__builtin_amdgcn_mbcnt_hi(~0u, __builtin_amdgcn_mbcnt_lo(~0u, z)); asm volatile("" : "+v"(t)); return t; }
__device__ __forceinline__ float dpp_add(float v, int ctrl_sel) {
    const int x = __builtin_bit_cast(int, v); int y;
    if (ctrl_sel == 0) y = __builtin_amdgcn_update_dpp(x, x, 0xB1, 0xF, 0xF, false);
    else if (ctrl_sel == 1) y = __builtin_amdgcn_update_dpp(x, x, 0x4E, 0xF, 0xF, false);
    else if (ctrl_sel == 2) y = __builtin_amdgcn_update_dpp(x, x, 0x141, 0xF, 0xF, false);
    else y = __builtin_amdgcn_update_dpp(x, x, 0x140, 0xF, 0xF, false);
    return v + __builtin_bit_cast(float, y);
}
__device__ __forceinline__ float row16_sum(float v) { v = dpp_add(v, 0); v = dpp_add(v, 1); v = dpp_add(v, 2); v = dpp_add(v, 3); return v; }
__device__ __forceinline__ float wave_sum(float v) {
    v = row16_sum(v); const int x = __builtin_bit_cast(int, v);
    const float a = __builtin_bit_cast(float, __builtin_amdgcn_readlane(x, 0)), b = __builtin_bit_cast(float, __builtin_amdgcn_readlane(x, 16)),
                c = __builtin_bit_cast(float, __builtin_amdgcn_readlane(x, 32)), d = __builtin_bit_cast(float, __builtin_amdgcn_readlane(x, 48));
    return (a + b) + (c + d);
}
__device__ __forceinline__ int shflx_i(int v, int m, int lane) { return __builtin_amdgcn_ds_bpermute((lane ^ m) << 2, v); }
__device__ __forceinline__ float shflx(float v, int m, int lane) { return __builtin_bit_cast(float, shflx_i(__builtin_bit_cast(int, v), m, lane)); }
namespace pg8 {
#define PG8_LAS __attribute__((address_space(3)))
#define PG8_GAS __attribute__((address_space(1)))
typedef unsigned short bf16_t;
typedef short bf16x8 __attribute__((ext_vector_type(8)));
typedef float f32x4 __attribute__((ext_vector_type(4)));
typedef float f32x2 __attribute__((ext_vector_type(2)));
typedef unsigned u32x4 __attribute__((ext_vector_type(4)));
constexpr int BM = 256, BK = 64, HALF = 128, HTB = HALF * BK * 2  , STAGE_BYTES = 8 * HTB, NXCD = 8, WGM = 8;

__host__ __device__ __forceinline__ int lds_byte(int r, int c) { const int st = (r >> 4) * 2 + (c >> 5), rr = r & 15, cc = c & 31, ob = rr * 64 + cc * 2; return st * 1024 + (ob ^ (((ob >> 9) & 1) << 5)); }
__host__ __device__ __forceinline__ void stage_rc(int b, int& R, int& C) { const int st = b / 1024, sb = b % 1024, swz = sb ^ (((sb >> 9) & 1) << 5); R = (st >> 1) * 16 + swz / 64; C = (st & 1) * 32 + (swz % 64) / 2; }
__host__ __device__ __forceinline__ int perm32(int rho) { const int n = rho >> 4, i = rho & 15; return 8 * (i >> 2) + 4 * n + (i & 3); }

struct Unit { int pm, pn, pb, orow, ex; };
struct Gemm { const bf16_t* A; const bf16_t* Bt; int K; int wv; };

struct StaticOrder {
    int nM, nN, nwg, G, c;
    __device__ __forceinline__ void init(int M, int N, int G_, int c_) { nM = M / BM; nN = N / BM; nwg = nM * nN; G = G_; c = c_; }
    __device__ __forceinline__ bool next(int i, Unit& u) const {
        const long L = (long)i * G + c; if (L >= nwg) return false;
        int wgid = (int)L; { const int q = nwg / NXCD, r = nwg % NXCD, xcd = wgid % NXCD, off = wgid / NXCD; wgid = (xcd < r ? xcd * (q + 1) : r * (q + 1) + (xcd - r) * q) + off; }
        const int nig = WGM * nN, gid = wgid / nig, fm = gid * WGM, gsz = (nM - fm) < WGM ? (nM - fm) : WGM;
        u.pm = fm + ((wgid % nig) % gsz); u.pn = (wgid % nig) / gsz; u.pb = u.pn; u.orow = u.pm * BM; u.ex = 0; return true;
    }
    __device__ __forceinline__ int arow(const Unit& u, int r) const { return u.pm * BM + r; }
};

template <bool GATHER> struct MoeOrder {
    int v, G, nt, npn, tpx;
    const PG8_LAS int* tile_e; const PG8_LAS int* rowtab;
    int k0, kend;
    __device__ __forceinline__ int unit_k(int i) const { return k0 + i * 32 + (v & 31); }
    __device__ __forceinline__ int tile_of(int i) const { const int k = unit_k(i); if (k < 0 || k >= kend) return nt; const int x = v >> 5, t = k / npn; return t < tpx ? x * tpx + t : nt; }
    __device__ __forceinline__ bool next(int i, Unit& u) const {
        const int rt = tile_of(i); if (rt >= nt) return false;
        const int pn = unit_k(i) % npn; const int e = __builtin_amdgcn_readfirstlane(tile_e[rt]);
        u.pm = i; u.pn = pn; u.pb = e * npn + pn; u.orow = rt * BM; u.ex = e; return true;
    }
    __device__ __forceinline__ int arow(const Unit& u, int r) const { if constexpr (GATHER) return rowtab[u.pm * BM + r]; else return u.orow + r; }
};

typedef int i32x4 __attribute__((ext_vector_type(4)));
typedef int i32x8 __attribute__((ext_vector_type(8)));
constexpr int F8_SCALE_W = 121, F8_SCALE_A = 125;
__device__ __forceinline__ i32x8 cat16(bf16x8 a, bf16x8 b) { const i32x4 x = __builtin_bit_cast(i32x4, a), y = __builtin_bit_cast(i32x4, b); return __builtin_shufflevector(x, y, 0, 1, 2, 3, 4, 5, 6, 7); }
__device__ __forceinline__ void mfma_f8(f32x4& c, const i32x8& a, const i32x8& b, int sa, int sb) {
    asm volatile("v_mfma_scale_f32_16x16x128_f8f6f4 %0, %1, %2, %0, %3, %4 op_sel_hi:[0,0,0]" : "+v"(c) : "v"(a), "v"(b), "v"(sa), "v"(sb)); }
__device__ __forceinline__ void mfma_f8_first(f32x4& c, const i32x8& a, const i32x8& b, int sa, int sb) {
    asm volatile("v_mfma_scale_f32_16x16x128_f8f6f4 %0, %1, %2, 0, %3, %4 op_sel_hi:[0,0,0]" : "=&v"(c) : "v"(a), "v"(b), "v"(sa), "v"(sb)); }
__device__ __forceinline__ unsigned cvt_pk_bf16(float lo, float hi) { typedef float f2 __attribute__((ext_vector_type(2))); typedef __bf16 b2 __attribute__((ext_vector_type(2))); f2 v = {lo, hi}; b2 b = __builtin_convertvector(v, b2); return __builtin_bit_cast(unsigned, b); }

__device__ __forceinline__ void store8(bf16_t* p, f32x4 v0, f32x4 v1) { u32x4 w; w.x = cvt_pk_bf16(v0[0], v0[1]); w.y = cvt_pk_bf16(v0[2], v0[3]); w.z = cvt_pk_bf16(v1[0], v1[1]); w.w = cvt_pk_bf16(v1[2], v1[3]); *(PG8_GAS u32x4*)p = w; }
__device__ __forceinline__ float silu_f(float x) { return x * __builtin_amdgcn_rcpf(1.0f + __builtin_amdgcn_exp2f(-1.4426950408889634f * x)); }

struct NoPre {};
struct EpiRetIn {
    static constexpr bool PERM = true, AFTER_DRAIN = false; typedef NoPre Pre;
    __device__ __forceinline__ void prefetch(Pre&, const Unit&, int, int, int, int) const {}
    __device__ __forceinline__ void touch(Pre&) const {}
    bf16_t* O; const float* cosT; const float* sinT;
    __device__ __forceinline__ void operator()(const f32x4 (&acc)[2][2][4][2], const Unit& u, int wr, int wc, int fr, int fq, const Pre&) const {
        const int row0 = u.orow + wr * 64 + fr, col0 = u.pn * BM + wc * 32 + 8 * fq;
        if (u.pn < 8) {
            const float sc = u.pn >= 4 ? 0.08838834764831845f : 1.0f; const int toff = 4 * (4 * wc + fq);
#pragma unroll
            for (int ai = 0; ai < 2; ++ai) { f32x4 cs[4], sn[4];
#pragma unroll
                for (int m = 0; m < 4; ++m) { const int pos = (row0 + ai * HALF + m * 16) & 8191; cs[m] = *(const PG8_GAS f32x4*)(cosT + pos * 64 + toff); sn[m] = *(const PG8_GAS f32x4*)(sinT + pos * 64 + toff); }
#pragma unroll
                for (int m = 0; m < 4; ++m) { bf16_t* rowp = O + (size_t)(row0 + ai * HALF + m * 16) * 6144 + col0; const f32x4 c_ = cs[m] * sc, s_ = sn[m] * sc;
#pragma unroll
                    for (int bj = 0; bj < 2; ++bj) { const f32x4 v0 = acc[ai][bj][m][0], v1 = acc[ai][bj][m][1]; store8(rowp + bj * HALF, v0 * c_ - v1 * s_, v1 * c_ + v0 * s_); } }
                asm volatile("" ::: "memory"); }
        } else if (u.pn >= 16) {
#pragma unroll
            for (int ai = 0; ai < 2; ++ai)
#pragma unroll
                for (int m = 0; m < 4; ++m) { bf16_t* rowp = O + (size_t)(row0 + ai * HALF + m * 16) * 6144 + col0;
#pragma unroll
                    for (int bj = 0; bj < 2; ++bj) { f32x4 v0 = acc[ai][bj][m][0], v1 = acc[ai][bj][m][1];
#pragma unroll
                        for (int j = 0; j < 4; ++j) { v0[j] = silu_f(v0[j]); v1[j] = silu_f(v1[j]); }
                        store8(rowp + bj * HALF, v0, v1); } }
        } else {
#pragma unroll
            for (int ai = 0; ai < 2; ++ai)
#pragma unroll
                for (int m = 0; m < 4; ++m) { bf16_t* rowp = O + (size_t)(row0 + ai * HALF + m * 16) * 6144 + col0;
#pragma unroll
                    for (int bj = 0; bj < 2; ++bj) store8(rowp + bj * HALF, acc[ai][bj][m][0], acc[ai][bj][m][1]); }
        }
    }
};
template <long offk, long offv, long offq> struct EpiDiffQK {
    static constexpr bool PERM = true, AFTER_DRAIN = false; typedef NoPre Pre;
    __device__ __forceinline__ void prefetch(Pre&, const Unit&, int, int, int, int) const {}
    __device__ __forceinline__ void touch(Pre&) const {}
    bf16_t* O; int pn_off; float qscale; const float* cosT; const float* sinT;
    __device__ __forceinline__ void operator()(const f32x4 (&acc)[2][2][4][2], const Unit& u, int wr, int wc, int fr, int fq, const Pre&) const {
        const int t = u.pn + pn_off; const int row0 = u.orow + wr * 64 + fr;
        const long boff = t < 4 ? offk : (t < 8 ? offv : offq); const bool rope = !(t >= 4 && t < 8); const float scale = t >= 8 ? qscale : 1.0f;
        bf16_t* base = O + boff;
        const int col0 = (t & 3) * BM + wc * 32 + 8 * fq; const bool dorope = rope && ((wc & 1) == 0) && fq < 2;
#pragma unroll
        for (int ai = 0; ai < 2; ++ai) { f32x4 cs[4], sn[4];
#pragma unroll
            for (int m = 0; m < 4; ++m) { cs[m] = (f32x4){1.f, 1.f, 1.f, 1.f}; sn[m] = (f32x4){0.f, 0.f, 0.f, 0.f};
                if (dorope) { const int pos = (row0 + ai * HALF + m * 16) & 8191; cs[m] = *(const PG8_GAS f32x4*)(cosT + pos * 8 + 4 * fq); sn[m] = *(const PG8_GAS f32x4*)(sinT + pos * 8 + 4 * fq); } }
#pragma unroll
            for (int m = 0; m < 4; ++m) { bf16_t* rowp = base + (size_t)(row0 + ai * HALF + m * 16) * 1024 + col0; const f32x4 c_ = cs[m] * scale, s_ = sn[m] * scale;
#pragma unroll
                for (int bj = 0; bj < 2; ++bj) { const f32x4 v0 = acc[ai][bj][m][0], v1 = acc[ai][bj][m][1]; store8(rowp + bj * HALF, v0 * c_ - v1 * s_, v1 * c_ + v0 * s_); } }
            asm volatile("" ::: "memory"); }
    }
};
struct EpiBf16Res {
    static constexpr bool PERM = true, AFTER_DRAIN = false; typedef NoPre Pre;
    __device__ __forceinline__ void prefetch(Pre&, const Unit&, int, int, int, int) const {}
    __device__ __forceinline__ void touch(Pre&) const {}
    const bf16_t* res; bf16_t* out; float alpha;
    __device__ __forceinline__ void operator()(const f32x4 (&acc)[2][2][4][2], const Unit& u, int wr, int wc, int fr, int fq, const Pre&) const {
        const int row0 = u.orow + wr * 64 + fr, col0 = u.pn * BM + wc * 32 + 8 * fq;
#pragma unroll
        for (int ai = 0; ai < 2; ++ai) { u32x4 rr[4][2];
#pragma unroll
            for (int m = 0; m < 4; ++m)
#pragma unroll
                for (int bj = 0; bj < 2; ++bj) rr[m][bj] = *(const PG8_GAS u32x4*)(res + (size_t)(row0 + ai * HALF + m * 16) * 1024 + col0 + bj * HALF);
#pragma unroll
            for (int m = 0; m < 4; ++m) { const size_t off = (size_t)(row0 + ai * HALF + m * 16) * 1024 + col0;
#pragma unroll
                for (int bj = 0; bj < 2; ++bj) { const u32x4 r = rr[m][bj];
                    const f32x4 r0 = {__builtin_bit_cast(float, r.x << 16), __builtin_bit_cast(float, r.x & 0xffff0000u), __builtin_bit_cast(float, r.y << 16), __builtin_bit_cast(float, r.y & 0xffff0000u)};
                    const f32x4 r1 = {__builtin_bit_cast(float, r.z << 16), __builtin_bit_cast(float, r.z & 0xffff0000u), __builtin_bit_cast(float, r.w << 16), __builtin_bit_cast(float, r.w & 0xffff0000u)};
                    store8(out + off + bj * HALF, acc[ai][bj][m][0] + r0 * alpha, acc[ai][bj][m][1] + r1 * alpha); } }
            asm volatile("" ::: "memory"); }
    }
};
template <bool F8> struct EpiSwiglu {
    static constexpr bool PERM = true, AFTER_DRAIN = false; struct Pre { f32x4 b[4]; };
    void* O; const float* bias;
    __device__ __forceinline__ void prefetch(Pre& P, const Unit& u, int wr, int wc, int fr, int fq) const { const float* bp = bias + (size_t)u.ex * 2048 + u.pn * HALF + wc * 32 + 8 * fq;
        const float* bq = bp + 1024;
        asm volatile("global_load_dwordx4 %0, %4, off\n\tglobal_load_dwordx4 %1, %4, off offset:16\n\tglobal_load_dwordx4 %2, %5, off\n\tglobal_load_dwordx4 %3, %5, off offset:16" : "=&v"(P.b[0]), "=&v"(P.b[1]), "=&v"(P.b[2]), "=&v"(P.b[3]) : "v"(bp), "v"(bq) : "memory"); }
    __device__ __forceinline__ void touch(Pre&) const {}
    __device__ __forceinline__ void operator()(const f32x4 (&acc)[2][2][4][2], const Unit& u, int wr, int wc, int fr, int fq, const Pre& P) const {
        const int row0 = u.orow + wr * 64 + fr, c0 = u.pn * HALF + wc * 32 + 8 * fq;
        const f32x4 bg0 = P.b[0], bg1 = P.b[1], bl0 = P.b[2], bl1 = P.b[3];
#pragma unroll
        for (int ai = 0; ai < 2; ++ai)
#pragma unroll
            for (int m = 0; m < 4; ++m) { const size_t eo = (size_t)(row0 + ai * HALF + m * 16) * 1024 + c0;
                f32x4 g0 = acc[ai][0][m][0] + bg0, g1 = acc[ai][0][m][1] + bg1, l0 = acc[ai][1][m][0] + bl0, l1 = acc[ai][1][m][1] + bl1;
                constexpr float OS = F8 ? 4.0f : 1.0f;
#pragma unroll
                for (int hh = 0; hh < 2; ++hh) { f32x4& gv = hh ? g1 : g0; const f32x4& lv = hh ? l1 : l0;
#pragma unroll
                    for (int j = 0; j < 4; j += 2) {
                        f32x2 g = {fminf(gv[j], 7.0f), fminf(gv[j + 1], 7.0f)}, l = {fminf(fmaxf(lv[j], -7.0f), 7.0f), fminf(fmaxf(lv[j + 1], -7.0f), 7.0f)};
                        const f32x2 t = g * (-1.702f * 1.4426950408889634f); f32x2 e; e.x = __builtin_amdgcn_exp2f(t.x); e.y = __builtin_amdgcn_exp2f(t.y);
                        const f32x2 d = e + 1.0f; f32x2 s; s.x = __builtin_amdgcn_rcpf(d.x); s.y = __builtin_amdgcn_rcpf(d.y);
                        const f32x2 h = (g * s) * (l * OS + OS); gv[j] = h.x; gv[j + 1] = h.y; } }
                if constexpr (F8) { int w0 = __builtin_amdgcn_cvt_pk_fp8_f32(g0[0], g0[1], 0, false); w0 = __builtin_amdgcn_cvt_pk_fp8_f32(g0[2], g0[3], w0, true);
                    int w1 = __builtin_amdgcn_cvt_pk_fp8_f32(g1[0], g1[1], 0, false); w1 = __builtin_amdgcn_cvt_pk_fp8_f32(g1[2], g1[3], w1, true);
                    typedef int i32x2_ __attribute__((ext_vector_type(2))); *(PG8_GAS i32x2_*)((unsigned char*)O + eo) = (i32x2_){w0, w1}; }
                else store8((bf16_t*)O + eo, g0, g1); }
    }
};
template <bool F8> struct EpiDown {
    static constexpr bool PERM = true, AFTER_DRAIN = false; struct Pre { f32x4 b[2][2]; };
    void* O; const float* bias;
    __device__ __forceinline__ void prefetch(Pre& P, const Unit& u, int wr, int wc, int fr, int fq) const { const float* bp = bias + (size_t)u.ex * 1024 + u.pn * BM + wc * 32 + 8 * fq;
        asm volatile("global_load_dwordx4 %0, %4, off\n\tglobal_load_dwordx4 %1, %4, off offset:16\n\tglobal_load_dwordx4 %2, %4, off offset:512\n\tglobal_load_dwordx4 %3, %4, off offset:528" : "=&v"(P.b[0][0]), "=&v"(P.b[0][1]), "=&v"(P.b[1][0]), "=&v"(P.b[1][1]) : "v"(bp) : "memory"); }
    __device__ __forceinline__ void touch(Pre&) const {}
    __device__ __forceinline__ void operator()(const f32x4 (&acc)[2][2][4][2], const Unit& u, int wr, int wc, int fr, int fq, const Pre& P) const {
        const int row0 = u.orow + wr * 64 + fr, col0 = u.pn * BM + wc * 32 + 8 * fq;
        const f32x4 (&bv)[2][2] = P.b;
        if constexpr (F8) {
            typedef int i32x4_ __attribute__((ext_vector_type(4))); const bool odd = fq & 1;
#pragma unroll
            for (int ai = 0; ai < 2; ++ai)
#pragma unroll
                for (int bj = 0; bj < 2; ++bj)
#pragma unroll
                    for (int mp = 0; mp < 4; mp += 2) { int w[2][2];
#pragma unroll
                        for (int q = 0; q < 2; ++q) { const f32x4 v0 = acc[ai][bj][mp + q][0] + bv[bj][0], v1 = acc[ai][bj][mp + q][1] + bv[bj][1];
                            int t0 = __builtin_amdgcn_cvt_pk_fp8_f32(v0[0] * 32.0f, v0[1] * 32.0f, 0, false); t0 = __builtin_amdgcn_cvt_pk_fp8_f32(v0[2] * 32.0f, v0[3] * 32.0f, t0, true);
                            int t1 = __builtin_amdgcn_cvt_pk_fp8_f32(v1[0] * 32.0f, v1[1] * 32.0f, 0, false); t1 = __builtin_amdgcn_cvt_pk_fp8_f32(v1[2] * 32.0f, v1[3] * 32.0f, t1, true);
                            w[q][0] = t0; w[q][1] = t1; }
                        const int s0 = odd ? w[0][0] : w[1][0], s1 = odd ? w[0][1] : w[1][1];
                        const int ln_ = fr + 16 * fq; const int r0 = shflx_i(s0, 16, ln_), r1 = shflx_i(s1, 16, ln_);
                        const i32x4_ o = odd ? (i32x4_){r0, r1, w[1][0], w[1][1]} : (i32x4_){w[0][0], w[0][1], r0, r1};
                        const size_t eo = (size_t)(row0 + ai * HALF + (mp + (odd ? 1 : 0)) * 16) * 1024 + (col0 - (odd ? 8 : 0)) + bj * HALF;
                        *(PG8_GAS i32x4_*)((unsigned char*)O + eo) = o; }
        } else {
#pragma unroll
            for (int ai = 0; ai < 2; ++ai)
#pragma unroll
                for (int m = 0; m < 4; ++m) { const size_t eo = (size_t)(row0 + ai * HALF + m * 16) * 1024 + col0;
#pragma unroll
                    for (int bj = 0; bj < 2; ++bj) store8((bf16_t*)O + eo + bj * HALF, acc[ai][bj][m][0] + bv[bj][0], acc[ai][bj][m][1] + bv[bj][1]); }
        }
    }
};

template <class Epi, class Sched, bool ALIGN_EPI = false, bool SP2 = false, bool F8 = false, int KREP = 1>
__device__ __forceinline__ void gemm_phase(PG8_LAS unsigned char* lds, const Gemm g, const Sched& S, const Epi& E) {
    const int tid = tid_opaque(g.wv), wid = g.wv, lane = tid & 63, wr = wid >> 2, wc = wid & 3, fr = lane & 15, fq = lane >> 4;
    const int K = g.K, nt = K / BK;
    unsigned voffB[2];
#pragma unroll
    for (int i = 0; i < 2; ++i) { int R, C; stage_rc(tid * 16 + i * 8192, R, C); const int Rb = Epi::PERM ? ((R & ~31) + perm32(R & 31)) : R;
        voffB[i] = (unsigned)(Rb * K + C) * 2u; }
    const unsigned rowb = (unsigned)K * 2u;
    const size_t kstep = (size_t)(BK * 2);
    const size_t hstep = (size_t)HALF * K * 2;
    const size_t tstep = 2 * hstep;
    const unsigned ldsw = (unsigned)wid * 1024u;
    const int aoff = lds_byte(wr * 64 + fr, fq * 8), boff = lds_byte(wc * 32 + fr, fq * 8);
    const char* Ab = (const char*)g.A;
    int sc_w = (KREP == 1) ? (F8_SCALE_W + F8_SCALE_A) / 2 : F8_SCALE_W, sc_a = (KREP == 1) ? (F8_SCALE_W + F8_SCALE_A) / 2 : F8_SCALE_A - 1;
#define PG8_SA(b, h) (((b) * 2 + (h)) * HTB)
#define PG8_SB(b, h) ((4 + (b) * 2 + (h)) * HTB)
#define PG8_STAGE(bufoff, gbase, voff) do { _Pragma("unroll") for (int _i = 0; _i < 2; ++_i) \
        __builtin_amdgcn_global_load_lds((const unsigned*)((const char*)(gbase) + (voff)[_i]), (PG8_LAS unsigned*)(lds + (bufoff) + ldsw + _i * 8192), 16, 0, 0); } while (0)
#define PG8_STAGE_A(bufoff, kb, v0_, v1_) do { \
        __builtin_amdgcn_global_load_lds((const unsigned*)(Ab + (kb) + (v0_)), (PG8_LAS unsigned*)(lds + (bufoff) + ldsw), 16, 0, 0); \
        __builtin_amdgcn_global_load_lds((const unsigned*)(Ab + (kb) + (v1_)), (PG8_LAS unsigned*)(lds + (bufoff) + ldsw + 8192), 16, 0, 0); } while (0)
#define PG8_LDA(dst, b, h) do { _Pragma("unroll") for (int m = 0; m < 4; ++m) _Pragma("unroll") for (int k = 0; k < 2; ++k) dst[m][k] = *(const PG8_LAS bf16x8*)(lds + PG8_SA(b, h) + aoff + m * 2048 + k * 1024); } while (0)
#define PG8_LDB(dst, b, h) do { _Pragma("unroll") for (int n = 0; n < 2; ++n) _Pragma("unroll") for (int k = 0; k < 2; ++k) dst[n][k] = *(const PG8_LAS bf16x8*)(lds + PG8_SB(b, h) + boff + n * 2048 + k * 1024); } while (0)
#define PG8_MMA(ai, bj, At, Bt) do { __builtin_amdgcn_s_setprio(1); _Pragma("unroll") for (int m = 0; m < 4; ++m) _Pragma("unroll") for (int n = 0; n < 2; ++n) { \
        if constexpr (F8) mfma_f8(acc[ai][bj][m][n], cat16(Bt[n][0], Bt[n][1]), cat16(At[m][0], At[m][1]), sc_w, sc_a); \
        else { _Pragma("unroll") for (int k = 0; k < 2; ++k) acc[ai][bj][m][n] = __builtin_amdgcn_mfma_f32_16x16x32_bf16(Bt[n][k], At[m][k], acc[ai][bj][m][n], 0, 0, 0); } } __builtin_amdgcn_s_setprio(0); } while (0)
#define PG8_MMA_FIRST(ai, bj, At, Bt) do { if (!F8 || tt != 0) { PG8_MMA(ai, bj, At, Bt); } else { __builtin_amdgcn_s_setprio(1); _Pragma("unroll") for (int m = 0; m < 4; ++m) _Pragma("unroll") for (int n = 0; n < 2; ++n) { \
        if constexpr (F8) mfma_f8_first(acc[ai][bj][m][n], cat16(Bt[n][0], Bt[n][1]), cat16(At[m][0], At[m][1]), sc_w, sc_a); \
        else { acc[ai][bj][m][n] = __builtin_amdgcn_mfma_f32_16x16x32_bf16(Bt[n][0], At[m][0], (f32x4){0.f, 0.f, 0.f, 0.f}, 0, 0, 0); acc[ai][bj][m][n] = __builtin_amdgcn_mfma_f32_16x16x32_bf16(Bt[n][1], At[m][1], acc[ai][bj][m][n], 0, 0, 0); } } __builtin_amdgcn_s_setprio(0); } } while (0)
#define PG8_WAIT_V(n) asm volatile("s_waitcnt vmcnt(" #n ")" ::: "memory")
#define PG8_WAIT_L(n) asm volatile("s_waitcnt lgkmcnt(" #n ")" ::: "memory")
#define PG8_BAR __builtin_amdgcn_s_barrier()
#define PG8_SCHED __builtin_amdgcn_sched_barrier(0)
#define PG8_ROWS(u_, v_) do { _Pragma("unroll") for (int _i = 0; _i < 2; ++_i) { int _R, _C; stage_rc(tid * 16 + _i * 8192, _R, _C); _Pragma("unroll") for (int _h = 0; _h < 2; ++_h) (v_)[_h][_i] = (unsigned)S.arow((u_), _h * HALF + _R) * rowb + (unsigned)_C * 2u; } } while (0)
    Unit cur, nxt; int ui = 0;
    if (!S.next(0, cur)) return;
    f32x4 acc[2][2][4][2];
#pragma unroll
    for (int a = 0; a < 2; ++a)
#pragma unroll
        for (int b = 0; b < 2; ++b)
#pragma unroll
            for (int m = 0; m < 4; ++m)
#pragma unroll
                for (int n = 0; n < 2; ++n) acc[a][b][m][n] = (f32x4){0.f, 0.f, 0.f, 0.f};
    bf16x8 At[4][2], B0[2][2], B1[2][2];
    unsigned va[2][2];
    PG8_ROWS(cur, va);
    const char* cB = (const char*)g.Bt + (size_t)cur.pb * tstep;
    typename Epi::Pre pre;
    if constexpr (SP2) {
        PG8_STAGE(PG8_SB(0, 0), cB, voffB); PG8_STAGE(PG8_SB(0, 1), cB + hstep, voffB); PG8_STAGE_A(PG8_SA(0, 0), 0, va[0][0], va[0][1]); PG8_STAGE_A(PG8_SA(0, 1), 0, va[1][0], va[1][1]);
        if (wr == 1) PG8_BAR;
        PG8_WAIT_V(2); PG8_BAR;
        PG8_STAGE(PG8_SB(1, 0), cB + kstep, voffB); PG8_STAGE_A(PG8_SA(1, 0), kstep, va[0][0], va[0][1]); PG8_STAGE(PG8_SB(1, 1), cB + hstep + kstep, voffB);
        PG8_WAIT_V(6); PG8_BAR;
    } else {
        PG8_STAGE(PG8_SB(0, 0), cB, voffB); PG8_STAGE_A(PG8_SA(0, 0), 0, va[0][0], va[0][1]); PG8_STAGE(PG8_SB(0, 1), cB + hstep, voffB); PG8_STAGE_A(PG8_SA(0, 1), 0, va[1][0], va[1][1]);
        if (wr == 1) PG8_BAR;
        PG8_WAIT_V(4); PG8_BAR;
        PG8_STAGE(PG8_SB(1, 0), cB + kstep, voffB); PG8_STAGE_A(PG8_SA(1, 0), kstep, va[0][0], va[0][1]); PG8_STAGE(PG8_SB(1, 1), cB + hstep + kstep, voffB);
        PG8_WAIT_V(6); PG8_BAR;
    }
    for (;;) {
        const bool has_next = S.next(ui + 1, nxt);
        const char* nB = has_next ? (const char*)g.Bt + (size_t)nxt.pb * tstep : cB;
        for (int tt = 0; tt < nt * KREP; tt += 2) {
            const bool last = (tt == nt * KREP - 2); const int t = (KREP == 1) ? tt : (tt & (nt - 1)), t2 = (KREP == 1) ? tt + 2 : ((tt + 2) & (nt - 1));
            const size_t k1 = (size_t)(t + 1) * kstep;
            const size_t k2 = last ? 0 : (size_t)t2 * kstep, k3 = k2 + kstep;
            const char* b2 = last ? nB : cB + (size_t)t2 * kstep; const char* b3 = b2 + kstep;
            const unsigned a1_0 = va[1][0], a1_1 = va[1][1];
            if (last) E.prefetch(pre, cur, wr, wc, fr, fq);
            if (last && has_next) { PG8_ROWS(nxt, va); PG8_SCHED; }
            if constexpr (SP2) {
            PG8_LDB(B0, 0, 0); PG8_LDB(B1, 0, 1); PG8_SCHED; PG8_LDA(At, 0, 0); PG8_STAGE_A(PG8_SA(1, 1), k1, a1_0, a1_1);
            PG8_WAIT_V(8); PG8_WAIT_L(0); PG8_BAR; PG8_MMA_FIRST(0, 0, At, B0); PG8_MMA_FIRST(0, 1, At, B1); PG8_BAR; PG8_SCHED;
            PG8_LDA(At, 0, 1); PG8_STAGE(PG8_SB(0, 0), b2, voffB); PG8_STAGE(PG8_SB(0, 1), b2 + hstep, voffB); PG8_STAGE_A(PG8_SA(0, 0), k2, va[0][0], va[0][1]);
            PG8_WAIT_V(8); PG8_WAIT_L(0); PG8_BAR; PG8_MMA_FIRST(1, 0, At, B0); PG8_MMA_FIRST(1, 1, At, B1); PG8_BAR; PG8_SCHED;
            PG8_LDB(B0, 1, 0); PG8_LDB(B1, 1, 1); PG8_SCHED; PG8_LDA(At, 1, 0); PG8_STAGE_A(PG8_SA(0, 1), k2, va[1][0], va[1][1]);
            PG8_WAIT_V(8); PG8_WAIT_L(0); PG8_BAR; PG8_MMA(0, 0, At, B0); PG8_MMA(0, 1, At, B1); PG8_BAR; PG8_SCHED;
            PG8_LDA(At, 1, 1); PG8_STAGE(PG8_SB(1, 0), b3, voffB); PG8_STAGE(PG8_SB(1, 1), b3 + hstep, voffB); PG8_STAGE_A(PG8_SA(1, 0), k3, va[0][0], va[0][1]);
            PG8_WAIT_V(8); PG8_WAIT_L(0); PG8_BAR; PG8_MMA(1, 0, At, B0); PG8_MMA(1, 1, At, B1); PG8_BAR; PG8_SCHED;
            } else {
            PG8_LDB(B0, 0, 0); PG8_SCHED; PG8_LDA(At, 0, 0); PG8_STAGE_A(PG8_SA(1, 1), k1, a1_0, a1_1);
            PG8_WAIT_L(8); PG8_BAR; PG8_WAIT_L(0); PG8_MMA(0, 0, At, B0); PG8_BAR; PG8_SCHED;
            PG8_LDB(B1, 0, 1); PG8_STAGE(PG8_SB(0, 0), b2, voffB);
            PG8_BAR; PG8_WAIT_L(0); PG8_MMA(0, 1, At, B1); PG8_BAR;
            PG8_LDA(At, 0, 1); PG8_STAGE_A(PG8_SA(0, 0), k2, va[0][0], va[0][1]);
            PG8_BAR; PG8_WAIT_L(0); PG8_MMA(1, 0, At, B0); PG8_BAR; PG8_SCHED;
            PG8_STAGE(PG8_SB(0, 1), b2 + hstep, voffB);
            PG8_WAIT_V(6); PG8_BAR; PG8_MMA(1, 1, At, B1); PG8_BAR;
            PG8_LDB(B0, 1, 0); PG8_SCHED; PG8_LDA(At, 1, 0); PG8_STAGE_A(PG8_SA(0, 1), k2, va[1][0], va[1][1]);
            PG8_WAIT_L(8); PG8_BAR; PG8_WAIT_L(0); PG8_MMA(0, 0, At, B0); PG8_BAR; PG8_SCHED;
            PG8_LDB(B1, 1, 1); PG8_STAGE(PG8_SB(1, 0), b3, voffB);
            PG8_BAR; PG8_WAIT_L(0); PG8_MMA(0, 1, At, B1); PG8_BAR;
            PG8_LDA(At, 1, 1); PG8_STAGE_A(PG8_SA(1, 0), k3, va[0][0], va[0][1]);
            PG8_BAR; PG8_WAIT_L(0); PG8_MMA(1, 0, At, B0); PG8_BAR; PG8_SCHED;
            PG8_STAGE(PG8_SB(1, 1), b3 + hstep, voffB);
            PG8_WAIT_V(6); PG8_BAR; PG8_MMA(1, 1, At, B1); PG8_BAR;
            }
            if (last) E.touch(pre);
        }
        if constexpr (ALIGN_EPI) { if (wr == 0) PG8_BAR; }
        if constexpr (F8) asm volatile("s_nop 15\n\ts_nop 15" ::: "memory");
        E(acc, cur, wr, wc, fr, fq, pre);
#if defined(EREP_PROBE)
        if constexpr (F8) { asm volatile("" ::: "memory");
#pragma unroll
            for (int a = 0; a < 2; ++a)
#pragma unroll
                for (int b = 0; b < 2; ++b)
#pragma unroll
                    for (int m = 0; m < 4; ++m)
#pragma unroll
                        for (int n = 0; n < 2; ++n) asm volatile("" : "+v"(acc[a][b][m][n]));
            E(acc, cur, wr, wc, fr, fq, pre); }
#endif
        if (!has_next) break;
#pragma unroll
        for (int a = 0; a < 2; ++a)
#pragma unroll
            for (int b = 0; b < 2; ++b)
#pragma unroll
                for (int m = 0; m < 4; ++m)
#pragma unroll
                    for (int n = 0; n < 2; ++n) { if constexpr (F8) asm volatile("" : "=v"(acc[a][b][m][n])); else acc[a][b][m][n] = (f32x4){0.f, 0.f, 0.f, 0.f}; }
        cur = nxt; cB = nB; ++ui;
        if constexpr (ALIGN_EPI) { if (wr == 1) PG8_BAR; }
    }
    PG8_WAIT_V(0);
    if constexpr (!ALIGN_EPI) { if (wr == 0) PG8_BAR; }
    PG8_BAR;
#undef PG8_SA
#undef PG8_SB
#undef PG8_STAGE
#undef PG8_STAGE_A
#undef PG8_LDA
#undef PG8_LDB
#undef PG8_MMA
#undef PG8_MMA_FIRST
#undef PG8_WAIT_V
#undef PG8_WAIT_L
#undef PG8_BAR
#undef PG8_SCHED
#undef PG8_ROWS
}
}
namespace attn_body {
using bf16=__hip_bfloat16;
using bf16x8=__attribute__((ext_vector_type(8)))short;
using s16x4=__attribute__((ext_vector_type(4)))short;
using f32x16=__attribute__((ext_vector_type(16)))float;
using u32x4=__attribute__((ext_vector_type(4)))unsigned;
constexpr int BATCH=4,NHEAD=16,SEQ=8192,D=64,DM=NHEAD*D,OPITCH=2048;
constexpr int NW=8,QBLK=32,QB=QBLK*NW,KVBLK=64,NQB=SEQ/QB;
constexpr int ATTN_PITCH=DM, ATTN_UNIT_ROWS=QB;
__device__ __forceinline__ int crow(int r,int hi){return (r&3)+8*(r>>2)+4*hi;}
#define SBAR() __builtin_amdgcn_sched_barrier(0)
__device__ __forceinline__ void cmask(f32x16&p0,f32x16&p1,int jb,int qrel,int hi){
  const float NEG=-INFINITY; int kb=64*jb+4*hi;
  #pragma unroll
  for(int r=0;r<16;++r){int kv=kb+(r&3)+8*(r>>2); if(kv>qrel)p0[r]=NEG; if(kv+32>qrel)p1[r]=NEG;}
}

constexpr int NSLOT=3, SLOTB=8192, SLOTV=2*SLOTB;
constexpr int LDS_K=0, LDS_V=NSLOT*SLOTB, LDS_WS=LDS_V+NSLOT*SLOTV, LDS_OST=LDS_WS+NW*64*4, LDS_BYTES=LDS_OST+NW*4096;
constexpr float C2=0.125f*1.4426950408889634f;
__device__ __forceinline__ void glds16(const void*gsrc,unsigned lds_dst){unsigned keep;
  asm volatile("s_mov_b32 %0, m0\n\ts_mov_b32 m0, %2\n\ts_nop 0\n\tglobal_load_lds_dwordx4 %1, off\n\ts_mov_b32 m0, %0":"=&s"(keep):"v"(gsrc),"s"(lds_dst):"memory");}
__device__ __forceinline__ float max3f(float a,float b,float c){float r;asm("v_max3_f32 %0, %1, %2, %3":"=v"(r):"v"(a),"v"(b),"v"(c));return r;}
__device__ __forceinline__ float max2f(float a,float b){float r;asm("v_max_f32_e32 %0, %1, %2":"=v"(r):"v"(a),"v"(b));return r;}
__device__ __forceinline__ float fadd_s(float a,float b){float r;asm("v_add_f32_e32 %0, %1, %2":"=v"(r):"v"(a),"v"(b));return r;}
__device__ __forceinline__ float fsub_s(float a,float b){float r;asm("v_sub_f32_e32 %0, %1, %2":"=v"(r):"v"(a),"v"(b));return r;}
typedef float f32x2_t __attribute__((ext_vector_type(2))); typedef __bf16 bf16x2_t __attribute__((ext_vector_type(2)));
__device__ __forceinline__ unsigned cvtpk_s(float lo,float hi){f32x2_t v={lo,hi};bf16x2_t b=__builtin_convertvector(v,bf16x2_t);return __builtin_bit_cast(unsigned,b);}
#define WAIT_BAR(N) asm volatile("s_waitcnt vmcnt(" #N ") lgkmcnt(0)\n\ts_barrier":::"memory")

__device__ __forceinline__ void qkt(f32x16&p0,f32x16&p1,const __attribute__((address_space(3))) char*Kslot,const bf16x8*qr,const f32x16&negm,int r32,int hi){
  const __attribute__((address_space(3))) char*kb=Kslot+hi*1024+r32*16;
  #pragma unroll
  for(int d0=0;d0<4;++d0){
    const bf16x8 b0=*(const __attribute__((address_space(3))) bf16x8*)(kb+d0*2048);
    const bf16x8 b1=*(const __attribute__((address_space(3))) bf16x8*)(kb+d0*2048+512);
    if(d0==0){p0=__builtin_amdgcn_mfma_f32_32x32x16_bf16(b0,qr[0],negm,0,0,0);p1=__builtin_amdgcn_mfma_f32_32x32x16_bf16(b1,qr[0],negm,0,0,0);}
    else{p0=__builtin_amdgcn_mfma_f32_32x32x16_bf16(b0,qr[d0],p0,0,0,0);p1=__builtin_amdgcn_mfma_f32_32x32x16_bf16(b1,qr[d0],p1,0,0,0);}}
}
typedef __attribute__((address_space(3))) const char* lds_cptr;
typedef short v4i16_t __attribute__((ext_vector_type(4)));
__device__ __forceinline__ void kload8(bf16x8*kf,lds_cptr kp){
  kf[0]=*(const __attribute__((address_space(3))) bf16x8*)(kp);      kf[1]=*(const __attribute__((address_space(3))) bf16x8*)(kp+512);
  kf[2]=*(const __attribute__((address_space(3))) bf16x8*)(kp+2048); kf[3]=*(const __attribute__((address_space(3))) bf16x8*)(kp+2560);
  kf[4]=*(const __attribute__((address_space(3))) bf16x8*)(kp+4096); kf[5]=*(const __attribute__((address_space(3))) bf16x8*)(kp+4608);
  kf[6]=*(const __attribute__((address_space(3))) bf16x8*)(kp+6144); kf[7]=*(const __attribute__((address_space(3))) bf16x8*)(kp+6656);
}
__device__ __forceinline__ void kload2(bf16x8*kf,lds_cptr kp,int j){ kf[2*j]=*(const __attribute__((address_space(3))) bf16x8*)(kp+j*2048); kf[2*j+1]=*(const __attribute__((address_space(3))) bf16x8*)(kp+j*2048+512); }
__device__ __forceinline__ s16x4 vtr(lds_cptr p){ return __builtin_bit_cast(s16x4,__builtin_amdgcn_ds_read_tr16_b64_v4i16((__attribute__((address_space(3))) v4i16_t*)p)); }
__device__ __forceinline__ float rowmax(const f32x16&p0,const f32x16&p1){
  float a=max3f(p0[0],p0[1],p1[0]),b=max3f(p0[2],p0[3],p1[1]);a=max3f(a,p1[2],p1[3]);
  #pragma unroll
  for(int r=4;r<16;r+=4){a=max3f(a,p0[r],p0[r+1]);b=max3f(b,p0[r+2],p0[r+3]);a=max3f(a,p1[r],p1[r+1]);b=max3f(b,p1[r+2],p1[r+3]);}
  const float m=max2f(a,b);
  auto rr=__builtin_amdgcn_permlane32_swap(__float_as_uint(m),__float_as_uint(m),false,false);
  return max2f(__uint_as_float(rr[0]),__uint_as_float(rr[1]));
}
__device__ __forceinline__ void pv(f32x16*o,int vb,bf16x8 pa0,bf16x8 pa1,bf16x8 pa2,bf16x8 pa3){
  #pragma unroll
  for(int d0=0;d0<4;++d0){s16x4 lo[4],hi[4];
    #pragma unroll
    for(int ks=0;ks<4;++ks){
      asm volatile("ds_read_b64_tr_b16 %0,%1 offset:%c2":"=&v"(lo[ks]):"v"(vb),"i"(d0*4096+ks*1024):"memory");
      asm volatile("ds_read_b64_tr_b16 %0,%1 offset:%c2":"=&v"(hi[ks]):"v"(vb),"i"(d0*4096+ks*1024+512):"memory");}
    asm volatile("s_waitcnt lgkmcnt(0)":::"memory");SBAR();
    #define PK(k) (bf16x8){lo[k][0],lo[k][1],lo[k][2],lo[k][3],hi[k][0],hi[k][1],hi[k][2],hi[k][3]}
    o[d0]=__builtin_amdgcn_mfma_f32_32x32x16_bf16(pa0,PK(0),o[d0],0,0,0);
    o[d0]=__builtin_amdgcn_mfma_f32_32x32x16_bf16(pa1,PK(1),o[d0],0,0,0);
    o[d0]=__builtin_amdgcn_mfma_f32_32x32x16_bf16(pa2,PK(2),o[d0],0,0,0);
    o[d0]=__builtin_amdgcn_mfma_f32_32x32x16_bf16(pa3,PK(3),o[d0],0,0,0);
    #undef PK
  }
}

#ifndef ATTN_STORE16
#define ATTN_STORE16(p,v) (*(__attribute__((address_space(1))) u32x4*)(p)=(v))
#endif
template<int THRL> __device__ __forceinline__ void attn_unit(int wv,int b,int h,int hv,int ocol,int qb,const bf16*Q,const bf16*__restrict__ K,const bf16*__restrict__ V,bf16*O,char*shm,bf16*OD,float lam,const float*subg,float lam_init){
  const int tid=tid_opaque(wv),lane=tid&63,r32=lane&31,hi=lane>>5; const int wid=wv;
  const long rowbase=(long)b*SEQ; const int q0=qb*QB;
  const bf16*Qw=Q+(rowbase+q0+wid*QBLK)*DM+h*D;
  const bf16*Kh=K+rowbase*DM+h*D,*Vh=V+rowbase*DM+hv*D;
  const unsigned lds0=(unsigned)(uintptr_t)shm;
  __attribute__((address_space(3))) float*wsf=(__attribute__((address_space(3))) float*)(shm+LDS_WS)+wid*64;
  const bf16*ksrc=Kh+(long)lane*DM+wid*8;
  const bf16*vsrc=Vh+(long)(16*(wid&3)+(lane>>2))*DM+(wid>>2)*32+(lane&3)*8;
  const unsigned kdst=lds0+LDS_K+wid*1024, vdst=lds0+LDS_V+wid*1024;
  #define DMA_K(t,slot) glds16(ksrc+(long)(t)*KVBLK*DM,(unsigned)__builtin_amdgcn_readfirstlane(kdst+(slot)))
  #define DMA_V(t,slot) do{ glds16(vsrc+(long)(t)*KVBLK*DM,(unsigned)__builtin_amdgcn_readfirstlane(vdst+2*(slot))); glds16(vsrc+(long)(t)*KVBLK*DM+64,(unsigned)__builtin_amdgcn_readfirstlane(vdst+2*(slot)+8192)); }while(0)
  const __attribute__((address_space(3))) char*Kbase=(const __attribute__((address_space(3))) char*)(shm+LDS_K); bf16x8 kf[8];
  const lds_cptr shm3=(lds_cptr)shm; const lds_cptr kp0=shm3+LDS_K+hi*1024+r32*16; const lds_cptr vp0=shm3+LDS_V+((lane>>4)&1)*32+(lane&3)*8+(4*hi+((lane&15)>>2))*64;
  const int NT=(q0+QB)/KVBLK;
  DMA_K(0,0);DMA_V(0,0);DMA_K(1,SLOTB);
  bf16x8 qr[4];
  #pragma unroll
  for(int d0=0;d0<4;++d0)qr[d0]=*(const __attribute__((address_space(1))) bf16x8*)(&Qw[(long)r32*DM+d0*16+hi*8]);
  float mhat=0.f,l_reg=0.f;f32x16 o[4];o[0]=f32x16{};o[1]=f32x16{};o[2]=f32x16{};o[3]=f32x16{};f32x16 negm=f32x16{};asm volatile("":"+v"(negm));
  const int qrel=wid*QBLK+r32;
  #define CMASK(P0,P1,t) do{int jb_=(t)-(NT-4); if(jb_>=0)cmask(P0,P1,jb_,qrel,hi);}while(0)
  bool resc=false;
  #define START(P0,P1) do{ const float rm=rowmax(P0,P1); resc=false; \
    { const float dl=rm; mhat=fadd_s(mhat,dl); \
      _Pragma("unroll") for(int r=0;r<16;++r){P0[r]=fsub_s(P0[r],dl);P1[r]=fsub_s(P1[r],dl);} \
      _Pragma("unroll") for(int r=0;r<16;++r)negm[r]=-mhat; asm volatile("":"+v"(negm)); } \
    _Pragma("unroll") for(int r=0;r<16;++r)P0[r]=__builtin_amdgcn_exp2f(P0[r]); }while(0)
  #define RESC() do{ if(resc){ asm volatile("s_waitcnt lgkmcnt(0)":::"memory"); \
      _Pragma("unroll") for(int d_=0;d_<4;++d_) _Pragma("unroll") for(int r=0;r<16;++r)o[d_][r]*=wsf[crow(r,hi)]; } }while(0)
  f32x16 pA0,pA1,pB0,pB1;
  int sl_prev=0,sl_cur=0,sl_next=SLOTB;
  #define ROT() do{sl_prev=sl_cur;sl_cur=sl_next;sl_next=(sl_next==(NSLOT-1)*SLOTB)?0:sl_next+SLOTB;}while(0)
  DMA_K(2,2*SLOTB);
  WAIT_BAR(3);
  qkt(pA0,pA1,Kbase,qr,negm,r32,hi);asm volatile("s_nop 15\n\ts_nop 7":"+v"(pA0),"+v"(pA1));CMASK(pA0,pA1,0);
  START(pA0,pA1);
  _Pragma("unroll") for(int r=0;r<16;++r)pA1[r]=__builtin_amdgcn_exp2f(pA1[r]);
  WAIT_BAR(0);
  DMA_K(3,0);DMA_V(1,SLOTB);
  ROT();
  kload8(kf,kp0+sl_cur);
  WAIT_BAR(3);
  s16x4 vlo[8],vhi[8]; u32x4 pw0,pw1,pw2,pw3;
  #define PKW(P,B) cvtpk_s(P[B],P[B+1])
  #define PAF(k) __builtin_bit_cast(bf16x8,pw##k)
  #define VFR(i) (bf16x8){vlo[i][0],vlo[i][1],vlo[i][2],vlo[i][3],vhi[i][0],vhi[i][1],vhi[i][2],vhi[i][3]}
  #define PIN(x) asm volatile("":"+v"(x))
  #define MX3(a,b,c) __builtin_fmaxf(__builtin_fmaxf((a),(b)),(c))
  #define GAPA(MF,A0,A1,A2,A3,W0,W1,PW) do{ MF; sacc+=A0; sacc+=A1; sacc+=A2; sacc+=A3; PIN(sacc); W0; W1; PIN(PW); SBAR(); }while(0)
  #define EX(v) __builtin_amdgcn_exp2f(v)
  #define GAPB(MF,X,B) do{ MF; X[B]=EX(X[B]); X[B+1]=EX(X[B+1]); PIN(X); SBAR(); }while(0)
  #define VRD2(i) do{ vlo[i]=vtr(vp_+((((i)>>2)+2)*4096+((i)&3)*1024)); vhi[i]=vtr(vp_+((((i)>>2)+2)*4096+((i)&3)*1024+512)); SBAR(); }while(0)
  #define VRD(i) do{ vlo[i]=vtr(vp_+(((i)>>2)*4096+((i)&3)*1024)); vhi[i]=vtr(vp_+(((i)>>2)*4096+((i)&3)*1024+512)); }while(0)
  #define KRD(G,j) do{ if(G){ kload2(kf,kp0+sl_next,j); SBAR(); } }while(0)
  #define STEP(C0,C1,P0,P1,t,GK,GV,GL) do{ SBAR(); \
    const lds_cptr vp_=vp0+2*sl_prev; \
    VRD(0); SBAR(); float sacc=(P0[0]+P0[1]); \
    GAPA(C0=__builtin_amdgcn_mfma_f32_32x32x16_bf16(kf[0],qr[0],negm,0,0,0), P0[2],P0[3],P0[4],P0[5],     pw0[0]=PKW(P0,0), pw0[1]=PKW(P0,2), pw0); \
    VRD(4); SBAR(); GAPA(C1=__builtin_amdgcn_mfma_f32_32x32x16_bf16(kf[1],qr[0],negm,0,0,0), P0[6],P0[7],P0[8],P0[9],     pw0[2]=PKW(P0,4), pw0[3]=PKW(P0,6), pw0); \
    VRD(1); SBAR(); GAPA(C0=__builtin_amdgcn_mfma_f32_32x32x16_bf16(kf[2],qr[1],C0,0,0,0),   P0[10],P0[11],P0[12],P0[13], pw1[0]=PKW(P0,8), pw1[1]=PKW(P0,10), pw1); \
    VRD(5); SBAR(); GAPA(C1=__builtin_amdgcn_mfma_f32_32x32x16_bf16(kf[3],qr[1],C1,0,0,0),   P0[14],P0[15],P1[0],P1[1],   pw1[2]=PKW(P0,12),pw1[3]=PKW(P0,14), pw1); \
    VRD(2); SBAR(); GAPA(C0=__builtin_amdgcn_mfma_f32_32x32x16_bf16(kf[4],qr[2],C0,0,0,0),   P1[2],P1[3],P1[4],P1[5],     pw2[0]=PKW(P1,0), pw2[1]=PKW(P1,2), pw2); \
    VRD(6); SBAR(); GAPA(C1=__builtin_amdgcn_mfma_f32_32x32x16_bf16(kf[5],qr[2],C1,0,0,0),   P1[6],P1[7],P1[8],P1[9],     pw2[2]=PKW(P1,4), pw2[3]=PKW(P1,6), pw2); \
    VRD(3); SBAR(); GAPA(C0=__builtin_amdgcn_mfma_f32_32x32x16_bf16(kf[6],qr[3],C0,0,0,0),   P1[10],P1[11],P1[12],P1[13], pw3[0]=PKW(P1,8), pw3[1]=PKW(P1,10), pw3); \
    VRD(7); SBAR(); GAPA(C1=__builtin_amdgcn_mfma_f32_32x32x16_bf16(kf[7],qr[3],C1,0,0,0),   P1[14],P1[15],0.f,0.f,       pw3[2]=PKW(P1,12),pw3[3]=PKW(P1,14), pw3); \
    l_reg+=sacc; \
    if(GK){DMA_K((t)+3,sl_cur);} if(GV){DMA_V((t)+1,sl_next);} \
    CMASK(C0,C1,t); \
    { float a=MX3(C0[0],C0[1],C1[0]),b=MX3(C0[2],C0[3],C1[1]); a=MX3(a,C1[2],C1[3]); \
      _Pragma("unroll") for(int r=4;r<16;r+=4){a=MX3(a,C0[r],C0[r+1]);b=MX3(b,C0[r+2],C0[r+3]);a=MX3(a,C1[r],C1[r+1]);b=MX3(b,C1[r+2],C1[r+3]);} \
      float rm=__builtin_fmaxf(a,b); { auto rr=__builtin_amdgcn_permlane32_swap(__float_as_uint(rm),__float_as_uint(rm),false,false); rm=__builtin_fmaxf(__uint_as_float(rr[0]),__uint_as_float(rr[1])); } \
      resc=false; \
      if(__builtin_expect(__any(rm>(float)THRL),0)){ const float dl=__builtin_fmaxf(rm,0.f); mhat+=dl; \
        _Pragma("unroll") for(int r=0;r<16;++r){C0[r]-=dl;C1[r]-=dl;} \
        _Pragma("unroll") for(int r=0;r<16;++r)negm[r]=-mhat; asm volatile("":"+v"(negm)); \
        const float f=__builtin_amdgcn_exp2f(-dl); l_reg*=f; if(hi==0)wsf[r32]=f; resc=true; } } \
    SBAR(); \
    GAPB(o[0]=__builtin_amdgcn_mfma_f32_32x32x16_bf16(PAF(0),VFR(0),o[0],0,0,0), C0,0); VRD2(0); \
    GAPB(o[1]=__builtin_amdgcn_mfma_f32_32x32x16_bf16(PAF(0),VFR(4),o[1],0,0,0), C0,2); VRD2(4); \
    GAPB(o[0]=__builtin_amdgcn_mfma_f32_32x32x16_bf16(PAF(1),VFR(1),o[0],0,0,0), C0,4); VRD2(1); \
    GAPB(o[1]=__builtin_amdgcn_mfma_f32_32x32x16_bf16(PAF(1),VFR(5),o[1],0,0,0), C0,6); VRD2(5); \
    GAPB(o[0]=__builtin_amdgcn_mfma_f32_32x32x16_bf16(PAF(2),VFR(2),o[0],0,0,0), C0,8); VRD2(2); \
    GAPB(o[1]=__builtin_amdgcn_mfma_f32_32x32x16_bf16(PAF(2),VFR(6),o[1],0,0,0), C0,10); VRD2(6); \
    GAPB(o[0]=__builtin_amdgcn_mfma_f32_32x32x16_bf16(PAF(3),VFR(3),o[0],0,0,0), C0,12); VRD2(3); \
    GAPB(o[1]=__builtin_amdgcn_mfma_f32_32x32x16_bf16(PAF(3),VFR(7),o[1],0,0,0), C0,14); VRD2(7); \
    GAPB(o[2]=__builtin_amdgcn_mfma_f32_32x32x16_bf16(PAF(0),VFR(0),o[2],0,0,0), C1,0); \
    KRD(GL,0); GAPB(o[3]=__builtin_amdgcn_mfma_f32_32x32x16_bf16(PAF(0),VFR(4),o[3],0,0,0), C1,2); \
    KRD(GL,1); GAPB(o[2]=__builtin_amdgcn_mfma_f32_32x32x16_bf16(PAF(1),VFR(1),o[2],0,0,0), C1,4); \
    KRD(GL,2); GAPB(o[3]=__builtin_amdgcn_mfma_f32_32x32x16_bf16(PAF(1),VFR(5),o[3],0,0,0), C1,6); \
    KRD(GL,3); GAPB(o[2]=__builtin_amdgcn_mfma_f32_32x32x16_bf16(PAF(2),VFR(2),o[2],0,0,0), C1,8); \
    GAPB(o[3]=__builtin_amdgcn_mfma_f32_32x32x16_bf16(PAF(2),VFR(6),o[3],0,0,0), C1,10); \
    GAPB(o[2]=__builtin_amdgcn_mfma_f32_32x32x16_bf16(PAF(3),VFR(3),o[2],0,0,0), C1,12); \
    GAPB(o[3]=__builtin_amdgcn_mfma_f32_32x32x16_bf16(PAF(3),VFR(7),o[3],0,0,0), C1,14); \
    }while(0)
  int t=1;
  #undef CMASK
  #define CMASK(P0,P1,t) do{}while(0)
  for(;t+5<NT;t+=2){
    STEP(pB0,pB1,pA0,pA1,t,true,true,true);     WAIT_BAR(3); RESC(); ROT();
    STEP(pA0,pA1,pB0,pB1,t+1,true,true,true);   WAIT_BAR(3); RESC(); ROT();
  }
  #undef CMASK
  #define CMASK(P0,P1,t) do{int jb_=(t)-(NT-4); if(jb_>=0)cmask(P0,P1,jb_,qrel,hi);}while(0)
  #define ENDW(tt) do{ if((tt)+3<NT){WAIT_BAR(3);} else if((tt)+2<NT){WAIT_BAR(2);} else {WAIT_BAR(0);} }while(0)
  for(;t+1<NT;t+=2){
    STEP(pB0,pB1,pA0,pA1,t,(t+3<NT),(t+1<NT),(t+1<NT));       ENDW(t);   RESC(); ROT();
    STEP(pA0,pA1,pB0,pB1,t+1,(t+4<NT),(t+2<NT),(t+2<NT));     ENDW(t+1); RESC(); ROT();
  }
  STEP(pB0,pB1,pA0,pA1,NT-1,false,false,false); RESC();
  { float sacc=pB0[0]+pB0[1]; _Pragma("unroll") for(int r=2;r<16;++r)sacc+=pB0[r]; _Pragma("unroll") for(int r=0;r<16;++r)sacc+=pB1[r]; l_reg+=sacc;
    pw0=(u32x4){PKW(pB0,0),PKW(pB0,2),PKW(pB0,4),PKW(pB0,6)};pw1=(u32x4){PKW(pB0,8),PKW(pB0,10),PKW(pB0,12),PKW(pB0,14)};pw2=(u32x4){PKW(pB1,0),PKW(pB1,2),PKW(pB1,4),PKW(pB1,6)};pw3=(u32x4){PKW(pB1,8),PKW(pB1,10),PKW(pB1,12),PKW(pB1,14)};
    SBAR(); pv(o,(int)(unsigned)(unsigned long)(vp0)+2*sl_cur,PAF(0),PAF(1),PAF(2),PAF(3)); }
  #undef PKW
  #undef PAF
  #undef VFR
  #undef PIN
  #undef MX3
  #undef GAPA
  #undef GAPB
  #undef EX
  #undef VRD
  #undef VRD2
  #undef KRD
  #undef STEP
  #undef ENDW
  {auto rr=__builtin_amdgcn_permlane32_swap(__float_as_uint(l_reg),__float_as_uint(l_reg),false,false);l_reg=__uint_as_float(rr[0])+__uint_as_float(rr[1]);}
  if(hi==0)wsf[32+r32]=l_reg;asm volatile("s_waitcnt lgkmcnt(0)":::"memory");
  float rli[16];
  #pragma unroll
  for(int r=0;r<16;++r)rli[r]=__builtin_amdgcn_rcpf(wsf[32+crow(r,hi)]);
  bf16*Ow=O+(rowbase+q0+wid*QBLK)*OPITCH+ocol;
  __attribute__((address_space(3))) unsigned short*stg=(__attribute__((address_space(3))) unsigned short*)(shm+LDS_OST)+wid*2048;
  if(!(h&1)){
    #pragma unroll
    for(int ps=0;ps<2;++ps){
      #pragma unroll
      for(int r=0;r<16;++r){const int orow=crow(r,hi);
        #pragma unroll
        for(int d0=0;d0<2;++d0)stg[orow*64+d0*32+r32]=__builtin_bit_cast(unsigned short,(__bf16)(o[2*ps+d0][r]*rli[r]));}
      asm volatile("s_waitcnt lgkmcnt(0)":::"memory");
      #pragma unroll
      for(int i=0;i<4;++i){const int row=i*8+(lane>>3),ch=lane&7; const u32x4 v=*(const __attribute__((address_space(3))) u32x4*)(stg+row*64+ch*8); ATTN_STORE16(Ow+(long)row*OPITCH+ps*64+ch*8,v);}
      asm volatile("s_waitcnt lgkmcnt(0)":::"memory"); }
  } else {
    float x[2][4][8]; float ss[4]={0.f,0.f,0.f,0.f};
    #pragma unroll
    for(int ps=0;ps<2;++ps){
      u32x4 v0[4];
      #pragma unroll
      for(int i=0;i<4;++i){const int row=i*8+(lane>>3),ch=lane&7; v0[i]=*(const __attribute__((address_space(1))) u32x4*)(Ow-128+(long)row*OPITCH+ps*64+ch*8);}
      #pragma unroll
      for(int r=0;r<16;++r){const int orow=crow(r,hi);
        #pragma unroll
        for(int d0=0;d0<2;++d0)stg[orow*64+d0*32+r32]=__builtin_bit_cast(unsigned short,(__bf16)(o[2*ps+d0][r]*rli[r]));}
      asm volatile("s_waitcnt lgkmcnt(0)":::"memory");
      #pragma unroll
      for(int i=0;i<4;++i){const int row=i*8+(lane>>3),ch=lane&7; const u32x4 v1=*(const __attribute__((address_space(3))) u32x4*)(stg+row*64+ch*8);
        #pragma unroll
        for(int k=0;k<4;++k){ const float a0=__uint_as_float(v0[i][k]<<16),a1=__uint_as_float(v0[i][k]&0xffff0000u),b0=__uint_as_float(v1[k]<<16),b1=__uint_as_float(v1[k]&0xffff0000u);
          const float y0=a0-lam*b0,y1=a1-lam*b1; x[ps][i][2*k]=y0; x[ps][i][2*k+1]=y1; ss[i]+=y0*y0+y1*y1; } }
      asm volatile("s_waitcnt lgkmcnt(0)":::"memory"); }
    bf16*ODw=OD+(rowbase+q0+wid*QBLK)*DM+(h>>1)*128;
    #pragma unroll
    for(int i=0;i<4;++i){ float s_=ss[i]; s_+=shflx(s_,1,lane); s_+=shflx(s_,2,lane); s_+=shflx(s_,4,lane); ss[i]=__builtin_amdgcn_rsqf(s_*(1.0f/128.0f)+1e-5f)*(1.0f-lam_init); }
    #pragma unroll
    for(int ps=0;ps<2;++ps){ const int ch=lane&7; const __attribute__((address_space(1))) u32x4*gp=(const __attribute__((address_space(1))) u32x4*)(subg+ps*64+ch*8); const u32x4 g0=gp[0],g1=gp[1];
      #pragma unroll
      for(int i=0;i<4;++i){const int row=i*8+(lane>>3); const float rs=ss[i]; u32x4 w;
        w[0]=cvtpk_s(x[ps][i][0]*rs*__uint_as_float(g0[0]),x[ps][i][1]*rs*__uint_as_float(g0[1])); w[1]=cvtpk_s(x[ps][i][2]*rs*__uint_as_float(g0[2]),x[ps][i][3]*rs*__uint_as_float(g0[3]));
        w[2]=cvtpk_s(x[ps][i][4]*rs*__uint_as_float(g1[0]),x[ps][i][5]*rs*__uint_as_float(g1[1])); w[3]=cvtpk_s(x[ps][i][6]*rs*__uint_as_float(g1[2]),x[ps][i][7]*rs*__uint_as_float(g1[3]));
        ATTN_STORE16(ODw+(long)row*DM+ps*64+ch*8,w);} }
  }
  asm volatile("s_waitcnt lgkmcnt(0)\n\ts_barrier":::"memory");
  #undef DMA_K
  #undef DMA_V
  #undef CMASK
  #undef START
  #undef RESC
  #undef ROT
}
constexpr int ATTN_LDS_BYTES=LDS_BYTES;
struct AttnTensors { const bf16* Q; const bf16* K; const bf16* V; bf16* O; int wv; bf16* OD; const float* lam4; const float* subg; float lam_init; };
struct AttnUnit { int b; int hq; int qb; };
struct DiffOrder {
  int vcu;
  __device__ __forceinline__ explicit DiffOrder(int v):vcu(v){}
  __device__ __forceinline__ bool next(int i,AttnUnit&u)const{ if(i>=8)return false; const int s=vcu&7,ii=i>>1; const int x=vcu>>3;
    u.b=x>>3; u.hq=2*(x&7)+(i&1); u.qb=(ii==0)?s:(ii==1)?15-s:(ii==2)?16+s:31-s; return true; }
};
template<class Sched,class Hook,int THRL=8> __device__ __forceinline__ void attn_phase(char*lds,const AttnTensors&T,const Sched&S,const Hook&H){
  AttnUnit u;
  const int ln_=tid_opaque(T.wv)&63; const __attribute__((address_space(1))) float*l4_=(const __attribute__((address_space(1))) float*)T.lam4; const float la_=wave_sum(l4_[ln_]*l4_[64+ln_]), lb_=wave_sum(l4_[128+ln_]*l4_[192+ln_]);
  const float lam=__uint_as_float(__builtin_amdgcn_readfirstlane(__float_as_uint(__expf(la_)-__expf(lb_)+T.lam_init)));
  for(int i=0;S.next(i,u);++i){ attn_unit<THRL>(T.wv,u.b,u.hq,(u.hq&~1),u.hq*128,u.qb,T.Q,T.K,T.V,T.O,lds,T.OD,lam,T.subg,T.lam_init); H(i,i==7); }
}
#undef SBAR
#undef WAIT_BAR
}

#ifndef MOE_FP8
#define MOE_FP8 1
#endif
constexpr int NWAVES = 8;
constexpr int T = 32768, D = 1024, SEQ = 8192, NBATCH = 4, DEPTH = 4;
constexpr int NE = 32, TOPK = 4, CAP = 32768, NROWS = T * TOPK + NE * 256;
constexpr int RH = 8, RDK = 128, RDV = 256, RC_ = 128, RNCH = SEQ / RC_;
constexpr float LN_EPS = 1e-5f;
constexpr float DN_ALPHA = 1.6817928305074292f;

constexpr size_t MiB = 1u << 20;
constexpr size_t WS_CTL = 0, CTL_ZERO_BYTES = 1 * MiB;
constexpr size_t WS_WRT = 1 * MiB;
constexpr size_t WS_ROPE_R = 2 * MiB;
constexpr size_t WS_ROPE_D = 6 * MiB;
constexpr size_t WS_TOKE = 7 * MiB, WS_TOKR = WS_TOKE + 512 * 1024, WS_TOKG = 8 * MiB;
constexpr size_t WS_ROWTOK = 12 * MiB;
constexpr size_t WS_WIN = 16 * MiB;
constexpr size_t WS_WROUT = 40 * MiB;
constexpr size_t WS_WKV = 48 * MiB;
constexpr size_t WS_WQ = 52 * MiB;
constexpr size_t WS_WDOUT = 56 * MiB;
#ifndef RET_F8
#define RET_F8 1
#endif
constexpr float RET_KS = 4.0f;
#ifndef CONV_IN_ATTN
#define CONV_IN_ATTN 1
#endif
constexpr size_t WS_WUP = 64 * MiB;
constexpr size_t WS_WDN = 576 * MiB;
constexpr size_t WS_HF = 832 * MiB;
constexpr size_t WS_HB = 960 * MiB;
constexpr size_t WS_SBUF = 1024 * MiB;
constexpr size_t WS_KSH = 1152 * MiB, WS_VSH = 1216 * MiB;
constexpr size_t WS_HQ = 1280 * MiB;
constexpr size_t WS_X = 1312 * MiB;
constexpr size_t WS_PROJ = WS_X, WS_KVT = WS_X + 384 * MiB, WS_STATE = WS_X + 640 * MiB, WS_OG = WS_X + 768 * MiB;
constexpr size_t WS_QD = WS_X, WS_OATT = WS_X + 64 * MiB, WS_OD = WS_X + 192 * MiB;
constexpr size_t WS_HDN = WS_X, WS_Y = WS_X + 272 * MiB;
constexpr size_t WS_END = WS_X + 896 * MiB;
static_assert((size_t)NROWS * 1024 * 2 <= 272 * MiB && (size_t)T * 6144 * 2 <= 384 * MiB, "ws map");
constexpr int CW_BAR = 4096;
constexpr int CW_CNT = 1024;

constexpr int RING_BYTES = 131072;
constexpr int LDSCTL_OFF = RING_BYTES;
constexpr int TAB_TILE_E = LDSCTL_OFF + 512;
constexpr int TAB_TSTART = TAB_TILE_E + 2304;
constexpr int TAB_ROWTAB = TAB_TSTART + 512;
constexpr int LDS_BYTES = TAB_ROWTAB + 18 * 1024;
static_assert(LDS_BYTES <= 163840 && LDS_BYTES % 16 == 0 && WAVE_TAB_LDS_OFF == LDSCTL_OFF + 256, "LDS map");

#define GAS __attribute__((address_space(1)))
#define LAS __attribute__((address_space(3)))
typedef unsigned short bf16;
typedef unsigned v4u __attribute__((ext_vector_type(4)));
typedef unsigned v2u __attribute__((ext_vector_type(2)));
typedef int v4i __attribute__((ext_vector_type(4)));
typedef float f32x4 __attribute__((ext_vector_type(4)));
typedef float f32x16 __attribute__((ext_vector_type(16)));
typedef short bf16x8 __attribute__((ext_vector_type(8)));
typedef short s16x4 __attribute__((ext_vector_type(4)));
typedef GAS unsigned gu32;
#define RLX_AGENT __ATOMIC_RELAXED, __HIP_MEMORY_SCOPE_AGENT
__device__ __forceinline__ unsigned f2bf(float f) { unsigned u = __builtin_bit_cast(unsigned, f); return (u + 0x7fffu + ((u >> 16) & 1u)) >> 16; }
__device__ __forceinline__ unsigned pk2(float lo, float hi) { return pg8::cvt_pk_bf16(lo, hi); }
__device__ __forceinline__ float bf2f(unsigned short b) { return __builtin_bit_cast(float, (unsigned)b << 16); }
__device__ __forceinline__ float bflo(unsigned w) { return __builtin_bit_cast(float, w << 16); }
__device__ __forceinline__ float bfhi(unsigned w) { return __builtin_bit_cast(float, w & 0xffff0000u); }

#define XB_TMO      128
#define XB_XCNT(j)  (256  + 64 * (j))
#define XB_XSUB(j)  (1280 + 64 * (j))
#define XB_XGEN(j)  (2304 + 64 * (j))
#define XB_TOP      3328
#define XB_TOPGEN   3392
#define XCD_BAR_WORDS 3456
#define XB_SPIN_CAP (1u << 22)

__device__ __forceinline__ unsigned xb_ld(unsigned* p)              { return __hip_atomic_load(p, __ATOMIC_RELAXED, __HIP_MEMORY_SCOPE_AGENT); }
__device__ __forceinline__ unsigned xb_add(unsigned* p, unsigned v) { return __hip_atomic_fetch_add(p, v, __ATOMIC_RELAXED, __HIP_MEMORY_SCOPE_AGENT); }
__device__ __forceinline__ unsigned xb_xcc_id() { return (unsigned)__builtin_amdgcn_s_getreg((3 << 11) | 20) & 0xFu; }
#define XB_SPIN(cond, bar) do { unsigned _sp = 0; while (cond) { __builtin_amdgcn_s_sleep(1); \
    if ((++_sp & 255u) == 0u) { if (xb_ld(&(bar)[XB_TMO])) break; if (_sp > XB_SPIN_CAP) { atomicAdd(&(bar)[XB_TMO], 1u); break; } } } } while (0)

struct XcdBarrier {
    unsigned* bar; unsigned x;
    volatile LAS unsigned* st; int wv;
};
__device__ __forceinline__ bool xb_thread0(int) { return tid_opaque(wave_index()) == 0; }
__device__ __forceinline__ XcdBarrier xcd_barrier_post(unsigned* bar, volatile LAS unsigned* st, int wv) {
    XcdBarrier b; b.bar = bar; b.x = xb_xcc_id(); b.st = st; b.wv = wv;
    if (xb_thread0(wv)) (void)xb_add(&bar[XB_XCNT(b.x)], 1u);
    return b;
}
__device__ __forceinline__ void xcd_barrier_complete(unsigned* bar, unsigned x, unsigned& nloc, unsigned& nx) {
    const unsigned G = gridDim.x * gridDim.y * gridDim.z;
    unsigned sum, cnt, mine, sp = 0u;
    for (;;) {
        sum = 0u; cnt = 0u; mine = 0u;
#pragma unroll
        for (unsigned j = 0; j < 16; ++j) { const unsigned c = xb_ld(&bar[XB_XCNT(j)]); sum += c; cnt += (c > 0u) ? 1u : 0u; mine = (j == x) ? c : mine; }
        if (sum == G) break;
        __builtin_amdgcn_s_sleep(1);
        if ((++sp & 255u) == 0u) { if (xb_ld(&bar[XB_TMO])) break; if (sp > XB_SPIN_CAP) { atomicAdd(&bar[XB_TMO], 1u); break; } }
    }
    nloc = mine > 0u ? mine : 1u; nx = cnt > 0u ? cnt : 1u;
}
__device__ __forceinline__ void xcd_barrier(const XcdBarrier& b) {
    asm volatile("s_waitcnt vmcnt(0)" ::: "memory");
    __syncthreads();
    if (xb_thread0(b.wv)) {
        unsigned* bar = b.bar;
        __builtin_amdgcn_s_waitcnt(0);
        unsigned nloc = b.st[0], nx = b.st[1];
        if (nloc == 0u) { xcd_barrier_complete(bar, b.x, nloc, nx); b.st[0] = nloc; b.st[1] = nx; }
        const unsigned old = xb_add(&bar[XB_XSUB(b.x)], 1u);
        const unsigned gen = old / nloc;
        if (old + 1u == (gen + 1u) * nloc) {
            __builtin_amdgcn_fence(__ATOMIC_RELEASE, "agent");
            asm volatile("s_waitcnt vmcnt(0)" ::: "memory");
            const unsigned og = xb_add(&bar[XB_TOP], 1u);
            const unsigned tg = og / nx;
            if (og + 1u == (tg + 1u) * nx) xb_add(&bar[XB_TOPGEN], 1u);
            else XB_SPIN(xb_ld(&bar[XB_TOPGEN]) == tg, bar);
            __builtin_amdgcn_fence(__ATOMIC_ACQUIRE, "agent");
            xb_add(&bar[XB_XGEN(b.x)], 1u);
            asm volatile("s_waitcnt vmcnt(0)" ::: "memory");
        } else {
            XB_SPIN(xb_ld(&bar[XB_XGEN(b.x)]) == gen, bar);
            __builtin_amdgcn_fence(__ATOMIC_ACQUIRE, "agent");
            asm volatile("s_waitcnt vmcnt(0)" ::: "memory");
        }
    }
    __syncthreads();
}
template <int MODE> __device__ __forceinline__ int dst_row(int n) {
    if (MODE == 1) { if (n < 2048) { const int d = n & 127; const int p = d < 64 ? (8 * (d >> 2) + (d & 3)) : (8 * ((d - 64) >> 2) + 4 + (d & 3)); return (n & ~127) + p; } return n; }
    if (MODE == 2) { if (n < 1024) { const int d = n & 63; if (d < 16) { const int p = d < 8 ? (8 * (d >> 2) + (d & 3)) : (8 * ((d - 8) >> 2) + 4 + (d & 3)); return (n & ~63) + p; } } return n; }
    if (MODE == 3) { return n < 1024 ? (256 * (n >> 7) + (n & 127)) : (256 * ((n - 1024) >> 7) + 128 + ((n - 1024) & 127)); }
    return n;
}
template <int MODE, bool FP8> __device__ __forceinline__ void transpose_item(const float* W_, int K, int N, unsigned char* WT, LAS unsigned* scr, int item, int lane) {
    const GAS float* W = (const GAS float*)W_;
    constexpr int R = FP8 ? 4 : 2, KI = 32 * R, EB = FP8 ? 1 : 2;
    const int nblk = N / 64, kb = item / nblk, nb = item - kb * nblk, k0 = KI * kb, n0 = 64 * nb;
    const int ks = lane >> 4, n4 = 4 * (lane & 15);
    f32x4 v[8][R];
#pragma unroll
    for (int i = 0; i < 8; ++i)
#pragma unroll
        for (int r = 0; r < R; ++r) v[i][r] = __builtin_nontemporal_load((const GAS f32x4*)(W + (size_t)(k0 + 4 * R * i + R * ks + r) * N + n0 + n4));
#pragma unroll
    for (int i = 0; i < 8; ++i) { LAS unsigned* row = scr + (4 * i + ks) * 65 + n4;
#pragma unroll
        for (int j = 0; j < 4; ++j) {
            unsigned w;
            if constexpr (FP8) { int t = __builtin_amdgcn_cvt_pk_fp8_f32(v[i][0][j] * 64.0f, v[i][1][j] * 64.0f, 0, false); t = __builtin_amdgcn_cvt_pk_fp8_f32(v[i][2][j] * 64.0f, v[i][3][j] * 64.0f, t, true); w = (unsigned)t; }
            else w = pk2(v[i][0][j], v[i][1][j]);
            row[j] = w; } }
    asm volatile("s_waitcnt lgkmcnt(0)" ::: "memory");
    const int c = lane & 7, nl = lane >> 3;
#pragma unroll
    for (int j = 0; j < 8; ++j) { const int n = nl + 8 * j; const LAS unsigned* s = scr + (4 * c) * 65 + n;
        v4u o; o.x = s[0]; o.y = s[65]; o.z = s[130]; o.w = s[195];
        __builtin_nontemporal_store(o, (GAS v4u*)(WT + ((size_t)dst_row<MODE>(n0 + n) * K + k0 + 4 * R * c) * EB)); }
    asm volatile("s_waitcnt lgkmcnt(0)" ::: "memory");
}
template <int MODE, bool FP8> __device__ __forceinline__ void transpose_all(const float* W, int K, int N, int nmat, void* WT, LAS unsigned* scr, int gw, int NGW, int lane) {
    constexpr int KI = FP8 ? 128 : 64, EB = FP8 ? 1 : 2;
    const int per = (K / KI) * (N / 64); const int total = per * nmat;
    for (int it = gw; it < total; it += NGW) { const int mat = it / per, item = it - mat * per; transpose_item<MODE, FP8>(W + (size_t)mat * K * N, K, N, (unsigned char*)WT + (size_t)mat * K * N * EB, scr, item, lane); }
}
__device__ __forceinline__ double exp2_d(double x) {
    const double n = __builtin_rint(x), z = (x - n) * 0.69314718055994530942;
    double p = 1.0 / 6227020800.0; p = p * z + 1.0 / 479001600.0; p = p * z + 1.0 / 39916800.0; p = p * z + 1.0 / 3628800.0; p = p * z + 1.0 / 362880.0; p = p * z + 1.0 / 40320.0; p = p * z + 1.0 / 5040.0;
    p = p * z + 1.0 / 720.0; p = p * z + 1.0 / 120.0; p = p * z + 1.0 / 24.0; p = p * z + 1.0 / 6.0; p = p * z + 0.5; p = p * z + 1.0; p = p * z + 1.0;
    return p * __builtin_bit_cast(double, (unsigned long long)(1023 + (long long)n) << 52);
}
__device__ __forceinline__ void sincos_d(double a, float& s, float& c) {
    const double k = __builtin_rint(a * 0.63661977236758134308), y = __builtin_fma(-k, 1.57079632679489661923, a) - k * 6.123233995736766e-17;
    const double y2 = y * y;
    double sp = -2.5052108385441718775e-8; sp = sp * y2 + 2.7557319223985890653e-6; sp = sp * y2 - 1.9841269841269841270e-4; sp = sp * y2 + 8.3333333333333333333e-3; sp = sp * y2 - 1.6666666666666666667e-1; sp = y + y * y2 * sp;
    double cp = 2.0876756987868098979e-9; cp = cp * y2 - 2.7557319223985890653e-7; cp = cp * y2 + 2.4801587301587301587e-5; cp = cp * y2 - 1.3888888888888888889e-3; cp = cp * y2 + 4.1666666666666666667e-2; cp = cp * y2 - 0.5; cp = 1.0 + y2 * cp;
    const int q = (int)((long long)k & 3);
    const double ss = (q == 0) ? sp : (q == 1) ? cp : (q == 2) ? -sp : -cp;
    const double cc = (q == 0) ? cp : (q == 1) ? -sp : (q == 2) ? -cp : sp;
    s = (float)ss; c = (float)cc;
}

struct Ptrs {
    const float *x, *ret_w_in, *ret_w_out, *kv_w, *diff_w_q, *diff_lambda, *diff_subln_g, *diff_w_out, *ln_attn_g, *ln_attn_b, *ln_ffn_g, *ln_ffn_b,
                *moe_w_router, *moe_b_router, *moe_w_up, *moe_b_up, *moe_w_down, *moe_b_down;
    float* out; unsigned char* ws;
    int ph_lo, ph_hi, li, pad;
};

enum PtrIdx { PI_X = 0, PI_RET_W_IN, PI_RET_W_OUT, PI_KV_W, PI_DIFF_W_Q, PI_DIFF_LAMBDA, PI_DIFF_SUBLN_G, PI_DIFF_W_OUT, PI_LN_ATTN_G, PI_LN_ATTN_B, PI_LN_FFN_G, PI_LN_FFN_B,
              PI_W_ROUTER, PI_B_ROUTER, PI_W_UP, PI_B_UP, PI_W_DOWN, PI_B_DOWN, PI_OUT, PI_WS, PI_N };
__device__ __forceinline__ unsigned long long ldp_raw(const LAS unsigned long long*, int i) {
    const __attribute__((address_space(4))) unsigned long long* kp = (const __attribute__((address_space(4))) unsigned long long*)__builtin_amdgcn_kernarg_segment_ptr();
    asm volatile("" : "+s"(kp));
    return kp[i];
}
#define LDPF(i) ((const float*)ldp_raw(PT, (i)))
constexpr int CONV_UP_ITEMS = 32 * (1024 / 128) * (2048 / 64), CONV_DN_ITEMS = 32 * (1024 / 128) * (1024 / 64);
struct ConvHook {
    const LAS unsigned long long* PT; LAS unsigned char* L; int l, gw, NGW, wv;
    __device__ __forceinline__ void one(int it, LAS unsigned* scr, int lane) const {
        unsigned char* ws = (unsigned char*)ldp_raw(PT, PI_WS);
        if (it < CONV_UP_ITEMS) { const int mat = it >> 8, item = it & 255;
            transpose_item<3, true>(LDPF(PI_W_UP) + ((size_t)l * 32 + mat) * 1024 * 2048, 1024, 2048, ws + WS_WUP + ((size_t)l * 32 + mat) * 2048 * 1024, scr, item, lane); }
        else if (it < CONV_UP_ITEMS + CONV_DN_ITEMS) { const int i2 = it - CONV_UP_ITEMS; const int mat = i2 >> 7, item = i2 & 127;
            transpose_item<0, true>(LDPF(PI_W_DOWN) + ((size_t)l * 32 + mat) * 1024 * 1024, 1024, 1024, ws + WS_WDN + ((size_t)l * 32 + mat) * 1024 * 1024, scr, item, lane); }
    }
    __device__ __forceinline__ void operator()(int i, bool lastu) const {
        const int lane = tid_opaque(wv) & 63; LAS unsigned* scr = (LAS unsigned*)(L + wv * 8448);
        if (!lastu) { if (gw - wv + NGW * i < CONV_UP_ITEMS + CONV_DN_ITEMS) { one(gw + NGW * i, scr, lane); asm volatile("s_waitcnt lgkmcnt(0)\n\ts_barrier" ::: "memory"); } }
        else for (int it = gw + NGW * i; it < CONV_UP_ITEMS + CONV_DN_ITEMS; it += NGW) one(it, scr, lane);
    }
};
struct NoHook { __device__ __forceinline__ void operator()(int, bool) const {} };
__device__ __forceinline__ void phase_prologue(LAS unsigned char* lds, const LAS unsigned long long* PT, int vcu, int G, int wv) {
    const int tid = tid_opaque(wv), lane = tid & 63, wave = wv;
    LAS unsigned* scr = (LAS unsigned*)(lds + wave * 8448);
    const int gw = vcu * NWAVES + wave, NGW = G * NWAVES;
    unsigned char* ws = (unsigned char*)ldp_raw(PT, PI_WS);
    transpose_all<3, MOE_FP8>(LDPF(PI_W_UP), 1024, 2048, CONV_IN_ATTN ? 64 : 128, (void*)(ws + WS_WUP), scr, gw, NGW, lane);
    transpose_all<0, MOE_FP8>(LDPF(PI_W_DOWN), 1024, 1024, CONV_IN_ATTN ? 64 : 128, (void*)(ws + WS_WDN), scr, gw, NGW, lane);
    transpose_all<1, false>(LDPF(PI_RET_W_IN), 1024, 6144, 2, (void*)(ws + WS_WIN), scr, gw, NGW, lane);
    transpose_all<0, false>(LDPF(PI_RET_W_OUT), 2048, 1024, 2, (void*)(ws + WS_WROUT), scr, gw, NGW, lane);
    transpose_all<2, false>(LDPF(PI_KV_W), 1024, 2048, 1, (void*)(ws + WS_WKV), scr, gw, NGW, lane);
    transpose_all<2, false>(LDPF(PI_DIFF_W_Q), 1024, 1024, 2, (void*)(ws + WS_WQ), scr, gw, NGW, lane);
    transpose_all<0, false>(LDPF(PI_DIFF_W_OUT), 1024, 1024, 2, (void*)(ws + WS_WDOUT), scr, gw, NGW, lane);
    const int gt = vcu * (NWAVES * 64) + tid, NGT = G * NWAVES * 64;
    { GAS float* cr = (GAS float*)(ws + WS_ROPE_R); GAS float* sr = cr + SEQ * 64;
      for (int i = gt; i < SEQ * 64; i += NGT) { const int pos = i >> 6, f = i & 63;
          const float lin = (float)f / 63.0f; const float inv = (float)exp2_d(-(double)lin * 13.287712379549449);
          const float ang = (float)pos * inv; float s, c; sincos_d((double)ang, s, c); cr[i] = c; sr[i] = s; }
      GAS float* cd = (GAS float*)(ws + WS_ROPE_D); GAS float* sd = cd + SEQ * 8;
      for (int i = gt; i < SEQ * 8; i += NGT) { const int pos = i >> 3, f = i & 7;
          const float ex = (float)(2 * f) / 16.0f; const float inv = (float)exp2_d(-(double)ex * 18.931568569324174);
          const float ang = (float)pos * inv; float s, c; sincos_d((double)ang, s, c); cd[i] = c; sd[i] = s; } }
    { GAS bf16* wrt = (GAS bf16*)(ws + WS_WRT); const GAS float* wrouter = (const GAS float*)LDPF(PI_W_ROUTER);
      for (int i = gt; i < DEPTH * 32 * 1024; i += NGT) { const int l = i >> 15, e = (i >> 10) & 31, k = i & 1023;
          const float w = wrouter[((size_t)l * 1024 + k) * 32 + e]; const unsigned hi = f2bf(w); const float r = w - bf2f((unsigned short)hi);
          wrt[((size_t)(l * 2 + 0) * 32 + e) * 1024 + k] = (bf16)hi; wrt[((size_t)(l * 2 + 1) * 32 + e) * 1024 + k] = (bf16)f2bf(r); } }
    { GAS bf16* hb = (GAS bf16*)(ws + WS_HB); const GAS float* xin = (const GAS float*)LDPF(PI_X);
      for (int i0 = gt; i0 < T * D / 8; i0 += 8 * NGT) {
          f32x4 a[8], b[8];
#pragma unroll
          for (int u = 0; u < 8; ++u) { const int i = i0 + u * NGT; if (i < T * D / 8) { a[u] = __builtin_nontemporal_load((const GAS f32x4*)(xin + (size_t)i * 8)); b[u] = __builtin_nontemporal_load((const GAS f32x4*)(xin + (size_t)i * 8 + 4)); } }
#pragma unroll
          for (int u = 0; u < 8; ++u) { const int i = i0 + u * NGT; if (i < T * D / 8) { v4u o; o.x = pk2(a[u][0], a[u][1]); o.y = pk2(a[u][2], a[u][3]); o.z = pk2(b[u][0], b[u][1]); o.w = pk2(b[u][2], b[u][3]); *(GAS v4u*)(hb + (size_t)i * 8) = o; } } } }
}

__device__ __forceinline__ void block_rowstats(const float (&x)[4][8], LAS float* red, LAS float* red2, int w, int lane, float& mean, float& rstd) {
    const int row = lane & 15;
    float s = 0.f, q = 0.f;
#pragma unroll
    for (int i = 0; i < 4; ++i)
#pragma unroll
        for (int j = 0; j < 8; ++j) { s += x[i][j]; q += x[i][j] * x[i][j]; }
    s += shflx(s, 16, lane); s += shflx(s, 32, lane);
    q += shflx(q, 16, lane); q += shflx(q, 32, lane);
    if (lane < 16) { red[w * 16 + row] = s; red2[w * 16 + row] = q; }
    __syncthreads();
    float tot = 0.f, tq = 0.f;
#pragma unroll
    for (int k = 0; k < 8; ++k) { tot += red[k * 16 + row]; tq += red2[k * 16 + row]; }
    mean = tot * (1.0f / 1024.0f);
    const float var = __builtin_fmaxf(tq * (1.0f / 1024.0f) - mean * mean, 0.f);
    rstd = 1.0f / sqrtf(var + LN_EPS);
}

__device__ __forceinline__ void phase_R(LAS unsigned char* lds, const bf16* sbuf_, const float* gam_, const float* bet_, bf16* hb_, unsigned char* hq_, const bf16* wrt_, const float* brouter_,
                                        unsigned* gcnt_, int* row_tok_, int* tok_e_, int* tok_r_, float* tok_g_, float* stat_, int vcu, int G, int wv) {
    GAS float* stat = (GAS float*)stat_;
    const GAS bf16* sbuf = (const GAS bf16*)sbuf_; const GAS float* gam = (const GAS float*)gam_; const GAS float* bet = (const GAS float*)bet_; GAS bf16* hb = (GAS bf16*)hb_; GAS unsigned char* hq = (GAS unsigned char*)hq_;
    const GAS bf16* wrt = (const GAS bf16*)wrt_; const GAS float* brouter = (const GAS float*)brouter_; GAS unsigned* gcnt = (GAS unsigned*)gcnt_; GAS int* row_tok = (GAS int*)row_tok_; GAS int* tok_e = (GAS int*)tok_e_; GAS int* tok_r = (GAS int*)tok_r_; GAS float* tok_g = (GAS float*)tok_g_;
    const int tid = tid_opaque(wv), lane = tid & 63, w = wv, row = lane & 15, kg = lane >> 4;
    LAS float* red = (LAS float*)lds; LAS float* red2 = red + 128; LAS float* part = red + 256;
    LAS float* logit = part + 4096;
    LAS int* sel_e = (LAS int*)(logit + 128 * 33); LAS float* sel_g = (LAS float*)(sel_e + 512);
    LAS unsigned* hist = (LAS unsigned*)(sel_g + 512); LAS unsigned* basew = hist + 32;
    bf16x8 wh[4][2], wl[4][2];
#pragma unroll
    for (int s = 0; s < 4; ++s)
#pragma unroll
        for (int nt = 0; nt < 2; ++nt) { const size_t o = (size_t)(16 * nt + row) * 1024 + 128 * w + 32 * s + 8 * kg; wh[s][nt] = *(const GAS bf16x8*)(wrt + o); wl[s][nt] = *(const GAS bf16x8*)(wrt + 32 * 1024 + o); }
    f32x4 gmr[4][2], btr[4][2];
#pragma unroll
    for (int s = 0; s < 4; ++s) { const int c0 = 128 * w + 32 * s + 8 * kg; gmr[s][0] = *(const GAS f32x4*)(gam + c0); gmr[s][1] = *(const GAS f32x4*)(gam + c0 + 4); btr[s][0] = *(const GAS f32x4*)(bet + c0); btr[s][1] = *(const GAS f32x4*)(bet + c0 + 4); }
    for (int tb = vcu; tb < T / 128; tb += G) {
        if (tid < 32) hist[tid] = 0u;
        v4u xa[4];
        { const size_t rb0 = (size_t)(tb * 128 + row) * 1024 + 128 * w + 8 * kg;
#pragma unroll
          for (int s = 0; s < 4; ++s) xa[s] = *(const GAS v4u*)(sbuf + rb0 + 32 * s); }
        for (int it = 0; it < 8; ++it) {
            const int t = tb * 128 + it * 16 + row;
            const size_t rb = (size_t)t * 1024 + 128 * w + 8 * kg;
            float x[4][8];
#pragma unroll
            for (int s = 0; s < 4; ++s) { x[s][0] = bflo(xa[s].x); x[s][1] = bfhi(xa[s].x); x[s][2] = bflo(xa[s].y); x[s][3] = bfhi(xa[s].y); x[s][4] = bflo(xa[s].z); x[s][5] = bfhi(xa[s].z); x[s][6] = bflo(xa[s].w); x[s][7] = bfhi(xa[s].w); }
            if (it < 7) {
#pragma unroll
                for (int s = 0; s < 4; ++s) xa[s] = *(const GAS v4u*)(sbuf + rb + 16 * 1024 + 32 * s); }
            float mean, rstd; block_rowstats(x, red, red2, w, lane, mean, rstd);
            if (MOE_FP8 && w == 0 && lane < 16) { typedef float f32x2s __attribute__((ext_vector_type(2))); *(GAS f32x2s*)(stat + 2 * (size_t)t) = (f32x2s){mean, rstd}; }
            pg8::f32x4 acc0 = {0.f, 0.f, 0.f, 0.f}, acc1 = {0.f, 0.f, 0.f, 0.f};
#pragma unroll
            for (int s = 0; s < 4; ++s) {
                const f32x4 g0 = gmr[s][0], g1 = gmr[s][1], b0 = btr[s][0], b1 = btr[s][1];
                float y[8];
#pragma unroll
                for (int j = 0; j < 4; ++j) { y[j] = (x[s][j] - mean) * rstd * g0[j] + b0[j]; y[4 + j] = (x[s][4 + j] - mean) * rstd * g1[j] + b1[j]; }
                v4u hi; hi.x = pk2(y[0], y[1]); hi.y = pk2(y[2], y[3]); hi.z = pk2(y[4], y[5]); hi.w = pk2(y[6], y[7]);
                if (!MOE_FP8) *(GAS v4u*)(hb + rb + 32 * s) = hi;
                if (MOE_FP8) { int w0 = __builtin_amdgcn_cvt_pk_fp8_f32(y[0] * 4.0f, y[1] * 4.0f, 0, false); w0 = __builtin_amdgcn_cvt_pk_fp8_f32(y[2] * 4.0f, y[3] * 4.0f, w0, true);
                    int w1 = __builtin_amdgcn_cvt_pk_fp8_f32(y[4] * 4.0f, y[5] * 4.0f, 0, false); w1 = __builtin_amdgcn_cvt_pk_fp8_f32(y[6] * 4.0f, y[7] * 4.0f, w1, true);
                    *(GAS v2u*)(hq + rb + 32 * s) = (v2u){(unsigned)w0, (unsigned)w1}; }
                v4u lo; lo.x = pk2(y[0] - bflo(hi.x), y[1] - bfhi(hi.x)); lo.y = pk2(y[2] - bflo(hi.y), y[3] - bfhi(hi.y)); lo.z = pk2(y[4] - bflo(hi.z), y[5] - bfhi(hi.z)); lo.w = pk2(y[6] - bflo(hi.w), y[7] - bfhi(hi.w));
                const bf16x8 ah = __builtin_bit_cast(bf16x8, hi), al = __builtin_bit_cast(bf16x8, lo);
                acc0 = __builtin_amdgcn_mfma_f32_16x16x32_bf16(ah, wh[s][0], acc0, 0, 0, 0); acc0 = __builtin_amdgcn_mfma_f32_16x16x32_bf16(ah, wl[s][0], acc0, 0, 0, 0); acc0 = __builtin_amdgcn_mfma_f32_16x16x32_bf16(al, wh[s][0], acc0, 0, 0, 0);
                acc1 = __builtin_amdgcn_mfma_f32_16x16x32_bf16(ah, wh[s][1], acc1, 0, 0, 0); acc1 = __builtin_amdgcn_mfma_f32_16x16x32_bf16(ah, wl[s][1], acc1, 0, 0, 0); acc1 = __builtin_amdgcn_mfma_f32_16x16x32_bf16(al, wh[s][1], acc1, 0, 0, 0); }
#pragma unroll
            for (int r = 0; r < 4; ++r) { part[(w * 16 + 4 * kg + r) * 32 + row] = acc0[r]; part[(w * 16 + 4 * kg + r) * 32 + 16 + row] = acc1[r]; }
            __syncthreads();
            { const int tk = tid >> 5, e = tid & 31; float v = brouter[e];
#pragma unroll
              for (int k = 0; k < 8; ++k) v += part[(k * 16 + tk) * 32 + e];
              logit[(it * 16 + tk) * 33 + e] = v; }
        }
        __syncthreads();
        if (tid < 128) {
            float v[32];
#pragma unroll
            for (int e = 0; e < 32; ++e) v[e] = logit[tid * 33 + e];
            float tv[4]; int ti[4];
#pragma unroll
            for (int k = 0; k < 4; ++k) { float bv = -INFINITY; int bi = 0;
#pragma unroll
                for (int e = 0; e < 32; ++e) { const bool gt = v[e] > bv; bv = gt ? v[e] : bv; bi = gt ? e : bi; }
                tv[k] = bv; ti[k] = bi;
#pragma unroll
                for (int e = 0; e < 32; ++e) v[e] = (e == bi) ? -INFINITY : v[e]; }
            const float e1 = __expf(tv[1] - tv[0]), e2 = __expf(tv[2] - tv[0]), e3 = __expf(tv[3] - tv[0]); const float inv = 1.0f / (1.0f + e1 + e2 + e3);
            const int o = tid * 4;
            sel_e[o] = ti[0]; sel_e[o + 1] = ti[1]; sel_e[o + 2] = ti[2]; sel_e[o + 3] = ti[3];
            sel_g[o] = inv; sel_g[o + 1] = e1 * inv; sel_g[o + 2] = e2 * inv; sel_g[o + 3] = e3 * inv;
        }
        __syncthreads();
        const int e = sel_e[tid];
        const unsigned rl = __hip_atomic_fetch_add(hist + e, 1u, __ATOMIC_RELAXED, __HIP_MEMORY_SCOPE_WORKGROUP);
        __syncthreads();
        if (tid < 32) basew[tid] = __hip_atomic_fetch_add(gcnt + tid, hist[tid], __ATOMIC_RELAXED, __HIP_MEMORY_SCOPE_AGENT);
        __syncthreads();
        { const int r = (int)(basew[e] + rl), tok = tb * 128 + (tid >> 2);
          row_tok[(size_t)e * CAP + r] = tok; tok_e[tok * 4 + (tid & 3)] = e; tok_r[tok * 4 + (tid & 3)] = r; tok_g[tok * 4 + (tid & 3)] = sel_g[tid]; }
        __syncthreads();
    }
}

__device__ __forceinline__ void moe_tables(LAS unsigned char* ldsall, const unsigned* gcnt_, int wv) {
    const GAS unsigned* gcnt = (const GAS unsigned*)gcnt_;
    LAS int* tile_e = (LAS int*)(ldsall + TAB_TILE_E); LAS int* tstart = (LAS int*)(ldsall + TAB_TSTART);
    const int tid = tid_opaque(wv);
    if (tid < 64) {
        const int c = tid < 32 ? (int)gcnt[tid] : 0; const int nt = (c + 255) >> 8;
        int incl = nt;
#pragma unroll
        for (int o = 1; o < 32; o <<= 1) { const int v = __builtin_amdgcn_ds_bpermute(((tid - o) & 63) << 2, incl); if ((tid & 63) >= o) incl += v; }
        const int excl = incl - nt;
        if (tid < 32) { tstart[tid] = excl; tstart[64 + tid] = c; for (int k = 0; k < nt; ++k) tile_e[excl + k] = tid; }
        if (tid == 31) tstart[32] = incl;
    }
    __syncthreads();
}

__device__ __forceinline__ void phase_C(LAS unsigned char* ldsall, const bf16* hres_  , const float* stat_, const float* gama_, const float* beta_, const void* ybuf__, const int* tok_e_, const int* tok_r_, const float* tok_g_, const unsigned* gcnt,
                                        const float* gam_, const float* bet_, float* outf_, bf16* hb_, int vcu, int G, int wv) {
    const GAS bf16* hres = (const GAS bf16*)hres_; const GAS unsigned char* ybuf_ = (const GAS unsigned char*)ybuf__; const GAS int* tok_e = (const GAS int*)tok_e_; const GAS int* tok_r = (const GAS int*)tok_r_; const GAS float* tok_g = (const GAS float*)tok_g_;
    const GAS float* gam = (const GAS float*)gam_; const GAS float* bet = (const GAS float*)bet_; GAS float* outf = (GAS float*)outf_; GAS bf16* hb = (GAS bf16*)hb_;
    const int tid = tid_opaque(wv), lane = tid & 63, wave = wv;
    const LAS int* tstart = (const LAS int*)(ldsall + TAB_TSTART);
    moe_tables(ldsall, gcnt, wv);
    typedef float f32x2_ __attribute__((ext_vector_type(2))); constexpr int CROWS = 4;
    f32x4 gm[4], bt[4], ga[4], ba[4];
    const GAS float* stat = (const GAS float*)stat_;
#pragma unroll
    for (int j = 0; j < 4; ++j) { gm[j] = *(const GAS f32x4*)(gam + 4 * lane + 256 * j); bt[j] = *(const GAS f32x4*)(bet + 4 * lane + 256 * j);
        if (MOE_FP8) { ga[j] = *(const GAS f32x4*)((const GAS float*)gama_ + 4 * lane + 256 * j) * DN_ALPHA; ba[j] = *(const GAS f32x4*)((const GAS float*)beta_ + 4 * lane + 256 * j) * DN_ALPHA; } }
    const int gw = vcu * NWAVES + wave, NGW = G * NWAVES;
    for (int rg = gw; rg < T / 16; rg += NGW) {
        const int t0 = rg * 16;
        int myoff[4]; float myg[4]; float mymean = 0.f, myrstd = 0.f;
        if (MOE_FP8) { typedef float f32x2s __attribute__((ext_vector_type(2))); const f32x2s st = *(const GAS f32x2s*)(stat + 2 * (size_t)(t0 + (lane & 15))); mymean = st[0]; myrstd = st[1]; }
        { const int t = t0 + (lane & 15); const v4i e4 = *(const GAS v4i*)(tok_e + t * 4), r4 = *(const GAS v4i*)(tok_r + t * 4); const f32x4 g4 = *(const GAS f32x4*)(tok_g + t * 4);
#pragma unroll
          for (int k = 0; k < 4; ++k) { myoff[k] = tstart[e4[k]] * 256 + r4[k]; myg[k] = g4[k]; } }
        for (int i = 0; i < 16; i += CROWS) {
            v2u a[CROWS][4]; v2u yv[CROWS][4][4]; unsigned y8[CROWS][4][4]; float gk[CROWS][4];
#pragma unroll
            for (int r = 0; r < CROWS; ++r) { const size_t rb = (size_t)(t0 + i + r) * 1024 + 4 * lane;
#pragma unroll
                for (int j = 0; j < 4; ++j) a[r][j] = *(const GAS v2u*)(hres + rb + 256 * j);
#pragma unroll
                for (int k = 0; k < 4; ++k) { const size_t yo = (size_t)__builtin_amdgcn_readlane(myoff[k], i + r) * 1024 + 4 * lane; gk[r][k] = __builtin_bit_cast(float, __builtin_amdgcn_readlane(__builtin_bit_cast(int, myg[k]), i + r)) * (MOE_FP8 ? (1.0f / 32.0f) : 1.0f);
#pragma unroll
                    for (int j = 0; j < 4; ++j) { if (MOE_FP8) y8[r][k][j] = *(const GAS unsigned*)(ybuf_ + yo + 256 * j); else yv[r][k][j] = *(const GAS v2u*)((const GAS bf16*)ybuf_ + yo + 256 * j); } } }
#pragma unroll
            for (int r = 0; r < CROWS; ++r) { const size_t rb = (size_t)(t0 + i + r) * 1024 + 4 * lane;
                f32x4 x[4]; float s = 0.f;
                const float rmean = __builtin_bit_cast(float, __builtin_amdgcn_readlane(__builtin_bit_cast(int, mymean), i + r)), rrstd = __builtin_bit_cast(float, __builtin_amdgcn_readlane(__builtin_bit_cast(int, myrstd), i + r));
#pragma unroll
                for (int j = 0; j < 4; ++j) { const f32x4 v = (f32x4){bflo(a[r][j].x), bfhi(a[r][j].x), bflo(a[r][j].y), bfhi(a[r][j].y)};
                    if (MOE_FP8) x[j] = ((v - rmean) * rrstd) * ga[j] + ba[j]; else x[j] = v * DN_ALPHA;
#pragma unroll
                    for (int k = 0; k < 4; ++k) { const float g = gk[r][k];
                        if (MOE_FP8) { const f32x2_ lo2 = __builtin_amdgcn_cvt_pk_f32_fp8((int)y8[r][k][j], false), hi2 = __builtin_amdgcn_cvt_pk_f32_fp8((int)y8[r][k][j], true); x[j][0] += g * lo2[0]; x[j][1] += g * lo2[1]; x[j][2] += g * hi2[0]; x[j][3] += g * hi2[1]; }
                        else { const v2u y2 = yv[r][k][j]; x[j][0] += g * bflo(y2.x); x[j][1] += g * bfhi(y2.x); x[j][2] += g * bflo(y2.y); x[j][3] += g * bfhi(y2.y); } }
                    s += (x[j][0] + x[j][1]) + (x[j][2] + x[j][3]); }
                const float mean = wave_sum(s) * (1.0f / 1024.0f); float q = 0.f;
#pragma unroll
                for (int j = 0; j < 4; ++j) { x[j] = x[j] - mean; q += (x[j][0] * x[j][0] + x[j][1] * x[j][1]) + (x[j][2] * x[j][2] + x[j][3] * x[j][3]); }
                const float rstd = 1.0f / sqrtf(wave_sum(q) * (1.0f / 1024.0f) + LN_EPS);
#pragma unroll
                for (int j = 0; j < 4; ++j) { const f32x4 y = x[j] * rstd * gm[j] + bt[j];
                    if (outf) __builtin_nontemporal_store(y, (GAS f32x4*)(outf + rb + 256 * j));
                    if (hb) { v2u o; o.x = pk2(y[0], y[1]); o.y = pk2(y[2], y[3]); *(GAS v2u*)(hb + rb + 256 * j) = o; } }
            }
        }
    }
}

__device__ __forceinline__ void phase_subln(const bf16* oatt, const float* lam4  , const float* subg  , float lambda_init, bf16* od, int vcu, int G, int wv) {
    const int tid = tid_opaque(wv), lane = tid & 63, wave = wv;
    const float a = wave_sum(lam4[lane] * lam4[64 + lane]), b = wave_sum(lam4[128 + lane] * lam4[192 + lane]);
    const float lam = __expf(a) - __expf(b) + lambda_init;
    const int h = lane >> 3, c0 = (lane & 7) * 16;
    float gsc[16];
#pragma unroll
    for (int j = 0; j < 16; ++j) gsc[j] = subg[c0 + j] * (1.0f - lambda_init);
    const int gw = vcu * NWAVES + wave, NGW = G * NWAVES;
    for (int t = gw; t < T; t += NGW) {
        const bf16* p0 = oatt + (size_t)t * 2048 + (2 * h) * 128 + c0; const bf16* p1 = p0 + 128;
        const v4u a0 = *(const v4u*)p0, a1 = *(const GAS v4u*)(p0 + 8), b0 = *(const v4u*)p1, b1 = *(const GAS v4u*)(p1 + 8);
        float o[16];
        o[0] = bflo(a0.x) - lam * bflo(b0.x); o[1] = bfhi(a0.x) - lam * bfhi(b0.x); o[2] = bflo(a0.y) - lam * bflo(b0.y); o[3] = bfhi(a0.y) - lam * bfhi(b0.y);
        o[4] = bflo(a0.z) - lam * bflo(b0.z); o[5] = bfhi(a0.z) - lam * bfhi(b0.z); o[6] = bflo(a0.w) - lam * bflo(b0.w); o[7] = bfhi(a0.w) - lam * bfhi(b0.w);
        o[8] = bflo(a1.x) - lam * bflo(b1.x); o[9] = bfhi(a1.x) - lam * bfhi(b1.x); o[10] = bflo(a1.y) - lam * bflo(b1.y); o[11] = bfhi(a1.y) - lam * bfhi(b1.y);
        o[12] = bflo(a1.z) - lam * bflo(b1.z); o[13] = bfhi(a1.z) - lam * bfhi(b1.z); o[14] = bflo(a1.w) - lam * bflo(b1.w); o[15] = bfhi(a1.w) - lam * bfhi(b1.w);
        float q = 0.f;
#pragma unroll
        for (int j = 0; j < 16; ++j) q += o[j] * o[j];
        q += __shfl_xor(q, 1); q += __shfl_xor(q, 2); q += __shfl_xor(q, 4);
        const float rs = 1.0f / sqrtf(q * (1.0f / 128.0f) + LN_EPS);
        v4u w0, w1;
        w0.x = pk2(o[0] * rs * gsc[0], o[1] * rs * gsc[1]); w0.y = pk2(o[2] * rs * gsc[2], o[3] * rs * gsc[3]); w0.z = pk2(o[4] * rs * gsc[4], o[5] * rs * gsc[5]); w0.w = pk2(o[6] * rs * gsc[6], o[7] * rs * gsc[7]);
        w1.x = pk2(o[8] * rs * gsc[8], o[9] * rs * gsc[9]); w1.y = pk2(o[10] * rs * gsc[10], o[11] * rs * gsc[11]); w1.z = pk2(o[12] * rs * gsc[12], o[13] * rs * gsc[13]); w1.w = pk2(o[14] * rs * gsc[14], o[15] * rs * gsc[15]);
        bf16* q0 = od + (size_t)t * 1024 + h * 128 + c0;
        *(v4u*)q0 = w0; *(GAS v4u*)(q0 + 8) = w1;
    }
}
__device__ __forceinline__ float ret_log2g(int h) {
    return h == 0 ? -0.04580368961312479f : h == 1 ? -0.02272007650008353f : h == 2 ? -0.011315313227834146f : h == 3 ? -0.005646563141142062f :
           h == 4 ? -0.002820519062378663f : h == 5 ? -0.0014095702546713536f : h == 6 ? -0.0007046129765893728f : -0.00035226347162902144f;
}
typedef short v4i16_t __attribute__((ext_vector_type(4)));
__device__ __forceinline__ s16x4 ds_tr(const LAS unsigned char* p) { return __builtin_bit_cast(s16x4, __builtin_amdgcn_ds_read_tr16_b64_v4i16((LAS v4i16_t*)p)); }
__device__ __forceinline__ bf16x8 cat8(s16x4 lo, s16x4 hi) { return (bf16x8){lo[0], lo[1], lo[2], lo[3], hi[0], hi[1], hi[2], hi[3]}; }
__device__ __forceinline__ int crow16(int r, int hi) { return (r & 3) + 8 * (r >> 2) + 4 * hi; }
#define MFMA32(a, b, c) __builtin_amdgcn_mfma_f32_32x32x16_bf16((a), (b), (c), 0, 0, 0)
constexpr int RKS = 272, RVS = 528;
constexpr int R_KOFF = 0, R_BOFF = 128 * RKS;
static_assert(R_BOFF + 256 * RKS <= RING_BYTES && R_BOFF + 128 * RVS <= RING_BYTES, "retention LDS");

__device__ __forceinline__ void phase_RA(LAS unsigned char* lds, const bf16* proj_, bf16* kvt_, int vcu, int G, int wv) {
    const int tid = tid_opaque(wv), w = wv;
    const GAS bf16* proj = (const GAS bf16*)proj_; GAS bf16* kvt = (GAS bf16*)kvt_;
    constexpr int NU = NBATCH * RH * RNCH;
    v4u kreg[4], vreg[8];
#define RA_ISSUE(u_) do { int tl_ = tid; asm volatile("" : "+v"(tl_)); const int bh_ = (u_) >> 6, n_ = (u_) & 63, b_ = bh_ >> 3, h_ = bh_ & 7; const GAS bf16* pb_ = proj + ((size_t)b_ * SEQ + (size_t)n_ * RC_) * 6144 + h_ * 128; \
        _Pragma("unroll") for (int i = 0; i < 4; ++i) { const unsigned c = tl_ + 512 * i, m = c >> 4, ch = c & 15; kreg[i] = *(const GAS v4u*)(pb_ + (m * 6144u + 1024u + ch * 8u)); } \
        _Pragma("unroll") for (int i = 0; i < 8; ++i) { const unsigned c = tl_ + 512 * i, m = c >> 5, ch = c & 31; vreg[i] = *(const GAS v4u*)(pb_ + (m * 6144u + 2048u + h_ * 128u + ch * 8u)); } } while (0)
    if (vcu < NU) RA_ISSUE(vcu);
    for (int unit = vcu; unit < NU; unit += G) {
        const int h = (unit >> 6) & 7; const float l2g = ret_log2g(h);
        int tl = tid; asm volatile("" : "+v"(tl));
        const int lane = tl & 63, r32 = lane & 31, hi = lane >> 5, blk = (lane >> 4) & 1, q = (lane & 15) >> 2, p = lane & 3;
        __syncthreads();
#pragma unroll
        for (int i = 0; i < 4; ++i) { const int c = tl + 512 * i, m = c >> 4, ch = c & 15; const v4u v = kreg[i]; const float dk = __builtin_amdgcn_exp2f((float)(127 - m) * l2g);
            v4u o; o.x = pk2(bflo(v.x) * dk, bfhi(v.x) * dk); o.y = pk2(bflo(v.y) * dk, bfhi(v.y) * dk); o.z = pk2(bflo(v.z) * dk, bfhi(v.z) * dk); o.w = pk2(bflo(v.w) * dk, bfhi(v.w) * dk);
            *(LAS v4u*)(lds + R_KOFF + m * RKS + ch * 16) = o; }
#pragma unroll
        for (int i = 0; i < 8; ++i) { const int c = tl + 512 * i, m = c >> 5, ch = c & 31; *(LAS v4u*)(lds + R_BOFF + m * RVS + ch * 16) = vreg[i]; }
        __syncthreads();
        if (unit + G < NU) RA_ISSUE(unit + G);
        const int dt = w & 3, e0 = 128 * (w >> 2);
        f32x16 acc[4];
#pragma unroll
        for (int c = 0; c < 4; ++c)
#pragma unroll
            for (int r = 0; r < 16; ++r) acc[c][r] = 0.f;
#pragma unroll
        for (int ks = 0; ks < 8; ++ks) {
            const LAS unsigned char* ka = lds + R_KOFF + (16 * ks + 8 * hi + q) * RKS + (32 * dt + 16 * blk + 4 * p) * 2;
            const bf16x8 af = cat8(ds_tr(ka), ds_tr(ka + 4 * RKS));
#pragma unroll
            for (int c = 0; c < 4; ++c) {
                const LAS unsigned char* va = lds + R_BOFF + (16 * ks + 8 * hi + q) * RVS + (e0 + 32 * c + 16 * blk + 4 * p) * 2;
                const bf16x8 bfr = cat8(ds_tr(va), ds_tr(va + 4 * RVS));
                acc[c] = MFMA32(af, bfr, acc[c]); }
            __builtin_amdgcn_sched_barrier(0);
        }
#if RET_F8
        GAS unsigned char* o8 = (GAS unsigned char*)kvt + (size_t)unit * 32768;
#pragma unroll
        for (int c = 0; c < 4; ++c)
#pragma unroll
            for (int g = 0; g < 4; ++g) { int w8 = __builtin_amdgcn_cvt_pk_fp8_f32(acc[c][4 * g] * RET_KS, acc[c][4 * g + 1] * RET_KS, 0, false); w8 = __builtin_amdgcn_cvt_pk_fp8_f32(acc[c][4 * g + 2] * RET_KS, acc[c][4 * g + 3] * RET_KS, w8, true);
                *(GAS int*)(o8 + ((e0 + 32 * c + r32) * 128 + 32 * dt + 8 * g + 4 * hi)) = w8; }
#else
        GAS bf16* o = kvt + (size_t)unit * 32768;
#pragma unroll
        for (int c = 0; c < 4; ++c)
#pragma unroll
            for (int g = 0; g < 4; ++g) { v2u pw; pw.x = pk2(acc[c][4 * g], acc[c][4 * g + 1]); pw.y = pk2(acc[c][4 * g + 2], acc[c][4 * g + 3]);
                *(GAS v2u*)(o + ((e0 + 32 * c + r32) * 128 + 32 * dt + 8 * g + 4 * hi)) = pw; }
#endif
    }
#undef RA_ISSUE
}

__device__ __forceinline__ void phase_RB(const bf16* kvt, bf16* state, int vcu, int G, int wv) {
    const int gt = vcu * (NWAVES * 64) + tid_opaque(wv), NGT = G * NWAVES * 64;
    typedef float f32x2r __attribute__((ext_vector_type(2)));
    for (int i = gt; i < NBATCH * RH * 4096; i += NGT) {
        const int bh = i >> 12, qd = i & 4095; const float dec = __builtin_amdgcn_exp2f(128.0f * ret_log2g(bh & 7));
#if RET_F8
        const GAS unsigned char* src = (const GAS unsigned char*)kvt + (size_t)bh * 64 * 32768 + (size_t)qd * 8; GAS unsigned char* dst = (GAS unsigned char*)state + (size_t)bh * 64 * 32768 + (size_t)qd * 8;
        float st[8];
#pragma unroll
        for (int k = 0; k < 8; ++k) st[k] = 0.f;
        v2u kvn[8];
#pragma unroll
        for (int j = 0; j < 8; ++j) kvn[j] = *(const GAS v2u*)(src + (size_t)j * 32768);
        for (int n0 = 0; n0 < 64; n0 += 8) {
            v2u kv[8];
#pragma unroll
            for (int j = 0; j < 8; ++j) kv[j] = kvn[j];
            if (n0 + 8 < 64) {
#pragma unroll
                for (int j = 0; j < 8; ++j) kvn[j] = *(const GAS v2u*)(src + (size_t)(n0 + 8 + j) * 32768); }
#pragma unroll
            for (int j = 0; j < 8; ++j) { int o0 = __builtin_amdgcn_cvt_pk_fp8_f32(st[0], st[1], 0, false); o0 = __builtin_amdgcn_cvt_pk_fp8_f32(st[2], st[3], o0, true);
                int o1 = __builtin_amdgcn_cvt_pk_fp8_f32(st[4], st[5], 0, false); o1 = __builtin_amdgcn_cvt_pk_fp8_f32(st[6], st[7], o1, true);
                *(GAS v2u*)(dst + (size_t)(n0 + j) * 32768) = (v2u){(unsigned)o0, (unsigned)o1};
                const f32x2r a0 = __builtin_amdgcn_cvt_pk_f32_fp8((int)kv[j].x, false), a1 = __builtin_amdgcn_cvt_pk_f32_fp8((int)kv[j].x, true), a2 = __builtin_amdgcn_cvt_pk_f32_fp8((int)kv[j].y, false), a3 = __builtin_amdgcn_cvt_pk_f32_fp8((int)kv[j].y, true);
                st[0] = st[0] * dec + a0[0]; st[1] = st[1] * dec + a0[1]; st[2] = st[2] * dec + a1[0]; st[3] = st[3] * dec + a1[1];
                st[4] = st[4] * dec + a2[0]; st[5] = st[5] * dec + a2[1]; st[6] = st[6] * dec + a3[0]; st[7] = st[7] * dec + a3[1]; }
        }
#else
        const GAS bf16* src = (const GAS bf16*)kvt + (size_t)bh * 64 * 32768 + (size_t)qd * 8; GAS bf16* dst = (GAS bf16*)state + (size_t)bh * 64 * 32768 + (size_t)qd * 8;
        float st[8];
#pragma unroll
        for (int k = 0; k < 8; ++k) st[k] = 0.f;
        v4u kvn[8];
#pragma unroll
        for (int j = 0; j < 8; ++j) kvn[j] = *(const GAS v4u*)(src + (size_t)j * 32768);
        for (int n0 = 0; n0 < 64; n0 += 8) {
            v4u kv[8];
#pragma unroll
            for (int j = 0; j < 8; ++j) kv[j] = kvn[j];
            if (n0 + 8 < 64) {
#pragma unroll
                for (int j = 0; j < 8; ++j) kvn[j] = *(const GAS v4u*)(src + (size_t)(n0 + 8 + j) * 32768); }
#pragma unroll
            for (int j = 0; j < 8; ++j) { v4u o; o.x = pk2(st[0], st[1]); o.y = pk2(st[2], st[3]); o.z = pk2(st[4], st[5]); o.w = pk2(st[6], st[7]); *(GAS v4u*)(dst + (size_t)(n0 + j) * 32768) = o;
                st[0] = st[0] * dec + bflo(kv[j].x); st[1] = st[1] * dec + bfhi(kv[j].x); st[2] = st[2] * dec + bflo(kv[j].y); st[3] = st[3] * dec + bfhi(kv[j].y);
                st[4] = st[4] * dec + bflo(kv[j].z); st[5] = st[5] * dec + bfhi(kv[j].z); st[6] = st[6] * dec + bflo(kv[j].w); st[7] = st[7] * dec + bfhi(kv[j].w); }
        }
#endif
    }
}

__device__ __forceinline__ void phase_RC(LAS unsigned char* lds, const bf16* proj_, const bf16* state_, bf16* og_, int vcu, int G, int wv) {
    const int tid = tid_opaque(wv), w = wv;
    const int qb = w & 3, eh = w >> 2;
    const GAS bf16* proj = (const GAS bf16*)proj_; const GAS bf16* state = (const GAS bf16*)state_; GAS bf16* og = (GAS bf16*)og_;
    constexpr int NU = NBATCH * RH * RNCH;
    v4u kreg[4], sreg[RET_F8 ? 4 : 8], vreg[8]; bf16x8 qf[8]; v2u greg[16];
#define RC_ISSUE(u_) do { int tl_ = tid; asm volatile("" : "+v"(tl_)); const int bh_ = (u_) >> 6, n_ = (u_) & 63, b_ = bh_ >> 3, h_ = bh_ & 7; const GAS bf16* pb_ = proj + ((size_t)b_ * SEQ + (size_t)n_ * RC_) * 6144 + h_ * 128; const GAS bf16* sb_ = state + (size_t)(u_) * 32768; const GAS unsigned char* sb8_ = (const GAS unsigned char*)state + (size_t)(u_) * 32768; (void)sb_; (void)sb8_; \
        _Pragma("unroll") for (int i = 0; i < 4; ++i) { const unsigned c = tl_ + 512 * i, m = c >> 4, ch = c & 15; kreg[i] = *(const GAS v4u*)(pb_ + (m * 6144u + 1024u + ch * 8u)); } \
        if (RET_F8) { _Pragma("unroll") for (int i = 0; i < 4; ++i) { const unsigned c = tl_ + 512 * i; sreg[i] = *(const GAS v4u*)(sb8_ + c * 16u); } } \
        else { _Pragma("unroll") for (int i = 0; i < (RET_F8 ? 4 : 8); ++i) { const unsigned c = tl_ + 512 * i; sreg[i] = *(const GAS v4u*)(sb_ + c * 8u); } } \
        _Pragma("unroll") for (int ks = 0; ks < 8; ++ks) qf[ks] = *(const GAS bf16x8*)(pb_ + ((32u * qb + (tl_ & 31)) * 6144u + 16u * ks + 8u * ((tl_ >> 5) & 1))); } while (0)
    if (vcu < NU) RC_ISSUE(vcu);
    for (int unit = vcu; unit < NU; unit += G) {
        const int bh = unit >> 6, n = unit & 63, b = bh >> 3, h = bh & 7; const float l2g = ret_log2g(h);
        const size_t t0 = (size_t)b * SEQ + (size_t)n * RC_;
        int tl = tid; asm volatile("" : "+v"(tl));
        const int lane = tl & 63, r32 = lane & 31, hi = lane >> 5, blk = (lane >> 4) & 1, q = (lane & 15) >> 2, p = lane & 3;
        __syncthreads();
#pragma unroll
        for (int i = 0; i < 4; ++i) { const int c = tl + 512 * i, m = c >> 4, ch = c & 15; *(LAS v4u*)(lds + R_KOFF + m * RKS + ch * 16) = kreg[i]; }
#pragma unroll
        for (int i = 0; i < (RET_F8 ? 4 : 8); ++i) {
            if (RET_F8) { const int c = tl + 512 * i, e = c >> 3, ch = c & 7; const v4u s8 = sreg[i]; typedef float f32x2r __attribute__((ext_vector_type(2)));
                unsigned wd[8];
#pragma unroll
                for (int k = 0; k < 4; ++k) { const int w8 = (int)(k == 0 ? s8.x : k == 1 ? s8.y : k == 2 ? s8.z : s8.w); const f32x2r lo2 = __builtin_amdgcn_cvt_pk_f32_fp8(w8, false), hi2 = __builtin_amdgcn_cvt_pk_f32_fp8(w8, true); wd[2 * k] = pk2(lo2[0], lo2[1]); wd[2 * k + 1] = pk2(hi2[0], hi2[1]); }
                *(LAS v4u*)(lds + R_BOFF + e * RKS + ch * 32) = (v4u){wd[0], wd[1], wd[2], wd[3]}; *(LAS v4u*)(lds + R_BOFF + e * RKS + ch * 32 + 16) = (v4u){wd[4], wd[5], wd[6], wd[7]}; }
            else { const int c = tl + 512 * i, e = c >> 4, ch = c & 15; *(LAS v4u*)(lds + R_BOFF + e * RKS + ch * 16) = sreg[i]; } }
        __syncthreads();
        const GAS bf16* pb = proj + t0 * 6144 + h * 128;
#pragma unroll
        for (int i = 0; i < 8; ++i) { const unsigned c = tl + 512 * i, m = c >> 5, ch = c & 31; vreg[i] = *(const GAS v4u*)(pb + (m * 6144u + 2048u + h * 128u + ch * 8u)); }
        f32x16 acc[4];
#pragma unroll
        for (int c = 0; c < 4; ++c)
#pragma unroll
            for (int r = 0; r < 16; ++r) acc[c][r] = 0.f;
#pragma unroll
        for (int ks = 0; ks < 8; ++ks)
#pragma unroll
            for (int ct = 0; ct < 4; ++ct) {
                const bf16x8 bs = *(const LAS bf16x8*)(lds + R_BOFF + (128 * eh + 32 * ct + r32) * RKS + (16 * ks + 8 * hi) * 2);
                acc[ct] = MFMA32(qf[ks], bs, acc[ct]); if (ct == 3) __builtin_amdgcn_sched_barrier(0); }
#pragma unroll
        for (int r = 0; r < 16; ++r) { const float qd = __builtin_amdgcn_exp2f((float)(32 * qb + crow16(r, hi) + 1) * l2g) * (RET_F8 ? 1.0f / RET_KS : 1.0f);
#pragma unroll
            for (int ct = 0; ct < 4; ++ct) acc[ct][r] *= qd; }
        __syncthreads();
#pragma unroll
        for (int i = 0; i < 8; ++i) { const int c = tl + 512 * i, m = c >> 5, ch = c & 31; *(LAS v4u*)(lds + R_BOFF + m * RVS + ch * 16) = vreg[i]; }
        __syncthreads();
        for (int kb = 0; kb <= qb; ++kb) {
            f32x16 xs;
#pragma unroll
            for (int r = 0; r < 16; ++r) xs[r] = 0.f;
#pragma unroll
            for (int ks = 0; ks < 8; ++ks) {
                const bf16x8 kf = *(const LAS bf16x8*)(lds + R_KOFF + (32 * kb + r32) * RKS + (16 * ks + 8 * hi) * 2);
                xs = MFMA32(kf, qf[ks], xs); }
            const int qpos = 32 * qb + r32;
#pragma unroll
            for (int r = 0; r < 16; ++r) { const int df = qpos - (32 * kb + crow16(r, hi)); xs[r] = df >= 0 ? xs[r] * __builtin_amdgcn_exp2f((float)df * l2g) : 0.f; }
#pragma unroll
            for (int s = 0; s < 2; ++s) {
                v4u pw; pw.x = pk2(xs[8 * s], xs[8 * s + 1]); pw.y = pk2(xs[8 * s + 2], xs[8 * s + 3]); pw.z = pk2(xs[8 * s + 4], xs[8 * s + 5]); pw.w = pk2(xs[8 * s + 6], xs[8 * s + 7]);
                const bf16x8 pf = __builtin_bit_cast(bf16x8, pw);
#pragma unroll
                for (int ct = 0; ct < 4; ++ct) {
                    const LAS unsigned char* va = lds + R_BOFF + (32 * kb + 16 * s + 4 * hi + q) * RVS + (128 * eh + 32 * ct + 16 * blk + 4 * p) * 2;
                    const bf16x8 vf = cat8(ds_tr(va), ds_tr(va + 8 * RVS));
                    acc[ct] = MFMA32(pf, vf, acc[ct]); }
                __builtin_amdgcn_sched_barrier(0);
            }
        }
#pragma unroll
        for (int i = 0; i < 16; ++i) greg[i] = *(const GAS v2u*)(pb + ((w * 16u + i) * 6144u + 4096u + h * 128u + 4u * lane));
        __syncthreads();
        LAS float* ot = (LAS float*)lds;
#pragma unroll
        for (int ct = 0; ct < 4; ++ct)
#pragma unroll
            for (int r = 0; r < 16; ++r) ot[(32 * qb + crow16(r, hi)) * 256 + 128 * eh + 32 * ct + r32] = acc[ct][r];
        __syncthreads();
        if (unit + G < NU) RC_ISSUE(unit + G);
#pragma unroll
        for (int i = 0; i < 16; ++i) { const int c = w * 16 + i;
            const f32x4 v = *(const LAS f32x4*)(ot + c * 256 + 4 * lane);
            const float mean = wave_sum((v[0] + v[1]) + (v[2] + v[3])) * (1.0f / 256.0f);
            const f32x4 d = v - mean; const float var = wave_sum((d[0] * d[0] + d[1] * d[1]) + (d[2] * d[2] + d[3] * d[3])) * (1.0f / 256.0f);
            const float rs = 1.0f / sqrtf(var + LN_EPS);
            const v2u gv = greg[i];
            v2u o; o.x = pk2(d[0] * rs * bflo(gv.x), d[1] * rs * bfhi(gv.x)); o.y = pk2(d[2] * rs * bflo(gv.y), d[3] * rs * bfhi(gv.y));
            *(GAS v2u*)(og + t0 * 2048 + (c * 2048u + h * 256u + 4u * lane)) = o; if (i & 1) __builtin_amdgcn_sched_barrier(0); }
    }
#undef RC_ISSUE
}
#ifndef MK_SPLIT
#define MK_SPLIT 0
#endif
#ifndef ALIGN_U
#define ALIGN_U true
#endif
#ifndef KREP_U
#define KREP_U 1
#endif
#ifndef KREP_D
#define KREP_D 1
#endif
#ifndef PH_MASK
#define PH_MASK 0xFFFF
#endif
#define PHM(b) constexpr ((PH_MASK >> (b)) & 1)
#ifndef REP_MASK
#define REP_MASK 0
#endif
#define REP(b) for (int rep_ = 0; rep_ < 1 + (int)(((unsigned)REP_MASK >> (b)) & 1u); ++rep_)
constexpr int N_PHASE_IDS = 1 + 9 * DEPTH;
constexpr float ATTN_C2 = 0.18033688011112042f;

__global__ void __launch_bounds__(NWAVES * 64, 2) yoco_fwd(Ptrs P) {
    extern __shared__ __attribute__((aligned(16))) unsigned char lds[];
    LAS unsigned char* L = (LAS unsigned char*)lds;
    volatile LAS unsigned* MISC = (volatile LAS unsigned*)(L + LDSCTL_OFF);
    LAS unsigned long long* PTW = (LAS unsigned long long*)(L + LDSCTL_OFF + 64);
    const LAS unsigned long long* PT = PTW;
    const int tid = threadIdx.x;
    const int G = gridDim.x; int vcu; { const int bx = blockIdx.x; vcu = (G % 8 == 0) ? (bx % 8) * (G / 8) + bx / 8 : bx; }
    for (int u = tid; u < 128; u += NWAVES * 64) ((LAS unsigned*)(L + LDSCTL_OFF))[u] = 0u;
    __syncthreads();
    if ((tid & 63) == 0) ((LAS unsigned*)(L + LDSCTL_OFF + 256))[(unsigned)__builtin_amdgcn_s_getreg((5 << 11) | 4) & 63u] = (unsigned)(tid >> 6);
    if (tid == 0) {
        PTW[PI_X] = (unsigned long long)P.x; PTW[PI_RET_W_IN] = (unsigned long long)P.ret_w_in; PTW[PI_RET_W_OUT] = (unsigned long long)P.ret_w_out; PTW[PI_KV_W] = (unsigned long long)P.kv_w;
        PTW[PI_DIFF_W_Q] = (unsigned long long)P.diff_w_q; PTW[PI_DIFF_LAMBDA] = (unsigned long long)P.diff_lambda; PTW[PI_DIFF_SUBLN_G] = (unsigned long long)P.diff_subln_g; PTW[PI_DIFF_W_OUT] = (unsigned long long)P.diff_w_out;
        PTW[PI_LN_ATTN_G] = (unsigned long long)P.ln_attn_g; PTW[PI_LN_ATTN_B] = (unsigned long long)P.ln_attn_b; PTW[PI_LN_FFN_G] = (unsigned long long)P.ln_ffn_g; PTW[PI_LN_FFN_B] = (unsigned long long)P.ln_ffn_b;
        PTW[PI_W_ROUTER] = (unsigned long long)P.moe_w_router; PTW[PI_B_ROUTER] = (unsigned long long)P.moe_b_router; PTW[PI_W_UP] = (unsigned long long)P.moe_w_up; PTW[PI_B_UP] = (unsigned long long)P.moe_b_up;
        PTW[PI_W_DOWN] = (unsigned long long)P.moe_w_down; PTW[PI_B_DOWN] = (unsigned long long)P.moe_b_down; PTW[PI_OUT] = (unsigned long long)P.out; PTW[PI_WS] = (unsigned long long)P.ws;
    }
#if MK_SPLIT
    const int lo = P.ph_lo, hi = P.ph_hi; const int bar_li = P.li;
#else
    constexpr int lo = 0, hi = N_PHASE_IDS, bar_li = 0;
#endif
    (void)xcd_barrier_post((unsigned*)((gu32*)(P.ws + WS_CTL) + CW_BAR) + (size_t)bar_li * XCD_BAR_WORDS, MISC + 8, 0);
    __syncthreads();
#define IN(k) (lo <= (k) && (k) < hi)
#define SEAM(k) do { if ((k) + 1 < hi) { XcdBarrier bar_; bar_.bar = (unsigned*)((gu32*)((unsigned char*)ldp_raw(PT, PI_WS) + WS_CTL) + CW_BAR) + (size_t)bar_li * XCD_BAR_WORDS; bar_.x = xb_xcc_id(); bar_.st = (volatile LAS unsigned*)(L + LDSCTL_OFF) + 8; bar_.wv = 0; \
        xcd_barrier(bar_); if ((REP_MASK >> 15) & 1) xcd_barrier(bar_); } } while (0)
#define SITE_WS() unsigned char* const ws = (unsigned char*)ldp_raw(PT, PI_WS); const int wv = wave_index()

    if PHM(0) if (IN(0)) REP(0) { phase_prologue(L, PT, vcu, G, wave_index()); SEAM(0); }

    for (int l = 0; l < DEPTH; ++l) {
        const int pb = 1 + 9 * l;
        if PHM(1) if (IN(pb + 0)) REP(1) {
            SITE_WS(); const bf16* hb = (const bf16*)(ws + WS_HB);
            if (l < 2) { if PHM(12) {
                pg8::Gemm g{hb, (const bf16*)(ws + WS_WIN) + (size_t)l * 6144 * 1024, 1024, wv}; pg8::StaticOrder S; S.init(T, 6144, G, (int)blockIdx.x);
                pg8::EpiRetIn E{(bf16*)(ws + WS_PROJ), (const float*)(ws + WS_ROPE_R), (const float*)(ws + WS_ROPE_R) + SEQ * 64};
                pg8::gemm_phase<pg8::EpiRetIn, pg8::StaticOrder, true, true>(L, g, S, E); }
            } else if PHM(13) {
                const int N = (l == 2) ? 3072 : 1024;
                pg8::Gemm g{hb, (const bf16*)(ws + ((l == 2) ? WS_WKV : WS_WQ + (size_t)1024 * 1024 * 2)), 1024, wv}; pg8::StaticOrder S; S.init(T, N, G, (int)blockIdx.x);
                typedef pg8::EpiDiffQK<(long)(WS_KSH / 2), (long)(WS_VSH / 2), (long)(WS_QD / 2)> EpiQKV; EpiQKV E{(bf16*)ws, (l == 2) ? 0 : 8, ATTN_C2, (const float*)(ws + WS_ROPE_D), (const float*)(ws + WS_ROPE_D) + SEQ * 8};
                pg8::gemm_phase<EpiQKV, pg8::StaticOrder, true, true>(L, g, S, E);
            }
            SEAM(pb + 0);
        }
        if (IN(pb + 1)) REP(l < 2 ? 2 : 3) {
            SITE_WS();
            if (l < 2) { if PHM(2) phase_RA(L, (const bf16*)(ws + WS_PROJ), (bf16*)(ws + WS_KVT), vcu, G, wv); }
            else if PHM(3) { const attn_body::AttnTensors AT{(const attn_body::bf16*)(ws + WS_QD), (const attn_body::bf16*)(ws + WS_KSH), (const attn_body::bf16*)(ws + WS_VSH), (attn_body::bf16*)(ws + WS_OATT), wv,
                       (attn_body::bf16*)(ws + WS_OD), LDPF(PI_DIFF_LAMBDA) + (size_t)(l - 2) * 256, LDPF(PI_DIFF_SUBLN_G) + (size_t)(l - 2) * 128, l == 2 ? 0.4707130183435842f : 0.5560582041556406f};
                   const attn_body::DiffOrder S(vcu);
#if CONV_IN_ATTN
                   const ConvHook H{PT, L, l, vcu * NWAVES + wv, G * NWAVES, wv}; attn_body::attn_phase<attn_body::DiffOrder, ConvHook>((char*)lds, AT, S, H);
#else
                   attn_body::attn_phase<attn_body::DiffOrder, NoHook>((char*)lds, AT, S, NoHook{});
#endif
                 }
            SEAM(pb + 1);
        }
        if (IN(pb + 2) && l < 2) REP(4) {
            SITE_WS();
            if PHM(4) phase_RB((const bf16*)(ws + WS_KVT), (bf16*)(ws + WS_STATE), vcu, G, wv);
            SEAM(pb + 2);
        }
        if PHM(6) if (IN(pb + 3) && l < 2) REP(6) { SITE_WS(); phase_RC(L, (const bf16*)(ws + WS_PROJ), (const bf16*)(ws + WS_STATE), (bf16*)(ws + WS_OG), vcu, G, wv); SEAM(pb + 3); }
        if PHM(7) if (IN(pb + 4)) REP(7) {
            SITE_WS();
            const int K = (l < 2) ? 2048 : 1024;
            const size_t aoff_ = (l < 2) ? WS_OG : WS_OD, boff_ = (l < 2) ? WS_WROUT + (size_t)l * 1024 * 2048 * 2 : WS_WDOUT + (size_t)(l - 2) * 1024 * 1024 * 2;
            pg8::Gemm g{(const bf16*)(ws + aoff_), (const bf16*)(ws + boff_), K, wv};
            pg8::StaticOrder S; S.init(T, 1024, G, (int)blockIdx.x);
            pg8::EpiBf16Res E{(const bf16*)(ws + WS_HB), (bf16*)(ws + WS_SBUF), DN_ALPHA};
            pg8::gemm_phase<pg8::EpiBf16Res, pg8::StaticOrder, true, true>(L, g, S, E);
            SEAM(pb + 4);
        }
        if PHM(8) if (IN(pb + 5)) REP(8) {
            SITE_WS();
            const bool dummy = (rep_ == 0) && ((REP_MASK >> 8) & 1);
            phase_R(L, (const bf16*)(ws + WS_SBUF), LDPF(PI_LN_ATTN_G) + l * 1024, LDPF(PI_LN_ATTN_B) + l * 1024, (bf16*)(ws + WS_HB), (unsigned char*)(ws + WS_HQ), (const bf16*)(ws + WS_WRT) + (size_t)l * 2 * 32 * 1024, LDPF(PI_B_ROUTER) + l * 32,
                    (unsigned*)(ws + WS_CTL) + CW_CNT + l * 64 + (dummy ? 32 : 0), (int*)(ws + (dummy ? WS_Y : WS_ROWTOK)), (int*)(ws + (dummy ? WS_Y + 8 * MiB : WS_TOKE)), (int*)(ws + (dummy ? WS_Y + 9 * MiB : WS_TOKR)), (float*)(ws + (dummy ? WS_Y + 10 * MiB : WS_TOKG)), (float*)(ws + (dummy ? WS_Y + 11 * MiB : WS_HF)), vcu, G, wv);
            SEAM(pb + 5);
        }
        if PHM(9) if (IN(pb + 6)) REP(9) {
            SITE_WS(); const unsigned* gcnt = (const unsigned*)(ws + WS_CTL) + CW_CNT + l * 64; const GAS int* row_tok = (const GAS int*)(ws + WS_ROWTOK);
            moe_tables(L, gcnt, wv);
            const LAS int* tile_e = (const LAS int*)(L + TAB_TILE_E); const LAS int* tstart = (const LAS int*)(L + TAB_TSTART); LAS int* rowtab = (LAS int*)(L + TAB_ROWTAB);
            const int NT = __builtin_amdgcn_readfirstlane(tstart[32]); const int NX = G >> 5, TPX = (NT + NX - 1) / NX;
            const int LU = TPX & 3, NFULL = TPX >> 2;
            for (int part = 0; part < (LU ? 2 : 1); ++part) {
            pg8::MoeOrder<true> S{vcu, G, NT, 8, TPX, tile_e, rowtab, part ? NFULL * 32 : 0, part ? TPX * 8 : NFULL * 32};
            { const int t0_ = tid_opaque(wv); int tokv[9];
#pragma unroll
              for (int k = 0; k < 9; ++k) { const int idx = t0_ + k * NWAVES * 64; tokv[k] = 0; const int rt = S.tile_of(idx >> 8);
                  if ((idx >> 8) < 18 && rt < NT) { const int r = idx & 255, e = tile_e[rt]; const int rr = (rt - tstart[e]) * 256 + r; if (rr < tstart[64 + e]) tokv[k] = row_tok[(size_t)e * CAP + rr]; } }
#pragma unroll
              for (int k = 0; k < 9; ++k) { const int idx = t0_ + k * NWAVES * 64; if ((idx >> 8) < 18) rowtab[idx] = tokv[k]; } }
            __syncthreads();
            pg8::Gemm g{(const bf16*)(ws + (MOE_FP8 ? WS_HQ : WS_HB)), (const bf16*)(ws + WS_WUP + (size_t)l * 32 * 2048 * 1024 * (MOE_FP8 ? 1 : 2)), MOE_FP8 ? 512 : 1024, wv};
            pg8::EpiSwiglu<MOE_FP8> E{(void*)(ws + WS_HDN), LDPF(PI_B_UP) + (size_t)l * 32 * 2048};
            pg8::gemm_phase<pg8::EpiSwiglu<MOE_FP8>, pg8::MoeOrder<true>, true, true, MOE_FP8, KREP_U>(L, g, S, E);
            if (part == 0) SEAM(pb + 6);
            }
        }
        if PHM(10) if (IN(pb + 7)) REP(10) {
            SITE_WS(); const unsigned* gcnt = (const unsigned*)(ws + WS_CTL) + CW_CNT + l * 64;
            moe_tables(L, gcnt, wv);
            const LAS int* tile_e = (const LAS int*)(L + TAB_TILE_E); const LAS int* tstart = (const LAS int*)(L + TAB_TSTART);
            const int NT = __builtin_amdgcn_readfirstlane(tstart[32]); const int NX = G >> 5, TPX = (NT + NX - 1) / NX;
            const int LU = TPX & 3, EARLY = LU ? 32 - 8 * LU : 0;
            for (int part = (LU ? 0 : 1); part < 2; ++part) {
            pg8::MoeOrder<false> S{vcu, G, NT, 4, TPX, tile_e, nullptr, part ? EARLY : EARLY - 32, part ? TPX * 4 : EARLY};
            pg8::Gemm g{(const bf16*)(ws + WS_HDN), (const bf16*)(ws + WS_WDN + (size_t)l * 32 * 1024 * 1024 * (MOE_FP8 ? 1 : 2)), MOE_FP8 ? 512 : 1024, wv};
            pg8::EpiDown<MOE_FP8> E{(void*)(ws + WS_Y), LDPF(PI_B_DOWN) + (size_t)l * 32 * 1024};
            pg8::gemm_phase<pg8::EpiDown<MOE_FP8>, pg8::MoeOrder<false>, true, true, MOE_FP8, KREP_D>(L, g, S, E);
            SEAM(pb + 7);
            }
        }
        if PHM(11) if (IN(pb + 8)) REP(11) {
            SITE_WS();
            const bool dummy = (rep_ == 0) && ((REP_MASK >> 11) & 1);
            float* outp = (l == DEPTH - 1 && !dummy) ? (float*)ldp_raw(PT, PI_OUT) : (float*)nullptr;
            bf16* hbo = dummy ? (bf16*)(ws + WS_SBUF) : ((l == DEPTH - 1) ? (bf16*)nullptr : (bf16*)(ws + WS_HB));
            phase_C(L, (const bf16*)(ws + (MOE_FP8 ? WS_SBUF : WS_HB)), (const float*)(ws + WS_HF), LDPF(PI_LN_ATTN_G) + l * 1024, LDPF(PI_LN_ATTN_B) + l * 1024, (const void*)(ws + WS_Y), (const int*)(ws + WS_TOKE), (const int*)(ws + WS_TOKR), (const float*)(ws + WS_TOKG), (const unsigned*)(ws + WS_CTL) + CW_CNT + l * 64,
                    LDPF(PI_LN_FFN_G) + l * 1024, LDPF(PI_LN_FFN_B) + l * 1024, outp, hbo, vcu, G, wv);
            SEAM(pb + 8);
        }
    }
#undef IN
#undef SEAM
}

extern "C" void kernel_launch(void* const* d_in, const int* in_sizes, int n_in, void* d_out, int out_size, void* d_ws, size_t ws_size, hipStream_t stream) {
    static int grid = 0;
    if (grid == 0) {
        if (n_in != 18 || in_sizes[0] != T * D || out_size != T * D || ws_size < WS_END) { fprintf(stderr, "kernel_launch: unexpected shapes (n_in %d, in0 %d, out %d, ws %zu < %zu); nothing launched\n", n_in, n_in > 0 ? in_sizes[0] : -1, out_size, ws_size, (size_t)WS_END); grid = -1; return; }
        int dev = 0, cus = 0, per_cu = 0;
        if (hipGetDevice(&dev) != hipSuccess || hipDeviceGetAttribute(&cus, hipDeviceAttributeMultiprocessorCount, dev) != hipSuccess) { fprintf(stderr, "kernel_launch: device query failed\n"); grid = -1; return; }
        if (hipFuncSetAttribute((const void*)yoco_fwd, hipFuncAttributeMaxDynamicSharedMemorySize, LDS_BYTES) != hipSuccess) { fprintf(stderr, "kernel_launch: hipFuncSetAttribute failed\n"); grid = -1; return; }
        if (hipOccupancyMaxActiveBlocksPerMultiprocessor(&per_cu, (const void*)yoco_fwd, NWAVES * 64, LDS_BYTES) != hipSuccess || per_cu < 1)
            fprintf(stderr, "kernel_launch: note: occupancy query reports %d workgroups per CU\n", per_cu);
        (void)hipGetLastError();
        grid = cus;
    }
    if (grid < 0) return;
    if (hipMemsetAsync((char*)d_ws + WS_CTL, 0, CTL_ZERO_BYTES, stream) != hipSuccess) { fprintf(stderr, "kernel_launch: hipMemsetAsync failed\n"); return; }
    Ptrs p{};
    p.x = (const float*)d_in[0]; p.ret_w_in = (const float*)d_in[1]; p.ret_w_out = (const float*)d_in[2]; p.kv_w = (const float*)d_in[3]; p.diff_w_q = (const float*)d_in[4];
    p.diff_lambda = (const float*)d_in[5]; p.diff_subln_g = (const float*)d_in[6]; p.diff_w_out = (const float*)d_in[7]; p.ln_attn_g = (const float*)d_in[8]; p.ln_attn_b = (const float*)d_in[9];
    p.ln_ffn_g = (const float*)d_in[10]; p.ln_ffn_b = (const float*)d_in[11]; p.moe_w_router = (const float*)d_in[12]; p.moe_b_router = (const float*)d_in[13]; p.moe_w_up = (const float*)d_in[14];
    p.moe_b_up = (const float*)d_in[15]; p.moe_w_down = (const float*)d_in[16]; p.moe_b_down = (const float*)d_in[17];
    p.out = (float*)d_out; p.ws = (unsigned char*)d_ws;
#if MK_SPLIT
    int li = 0;
    for (int ph = 0; ph < N_PHASE_IDS; ++ph) {
        if (ph >= 1 && ((ph - 1) % 9) == 3 && (ph - 1) / 9 >= 2) continue;
        p.ph_lo = ph; p.ph_hi = ph + 1; p.li = li++; p.pad = 0;
        hipLaunchKernelGGL(yoco_fwd, dim3(grid), dim3(NWAVES * 64), LDS_BYTES, stream, p);
    }
#else
    p.ph_lo = 0; p.ph_hi = N_PHASE_IDS; p.li = 0; p.pad = 0;
    hipLaunchKernelGGL(yoco_fwd, dim3(grid), dim3(NWAVES * 64), LDS_BYTES, stream, p);
#endif
    const hipError_t le = hipPeekAtLastError();
    if (le != hipSuccess) fprintf(stderr, "kernel_launch: launch failed: %s (grid %d)\n", hipGetErrorName(le), grid);
}
```
